# Optimizing an MI355X kernel written in HIP

```python
import jax, jax.numpy as jnp
from jax import lax
import numpy as np

D_MODEL = 1024
BATCH = 4
SEQ = 4096
DEPTH = 4

N_HEADS = 8
HEAD_DIM = 64
ATT_WIDTH = N_HEADS * HEAD_DIM
POOL_GROUPS = 4
POOL_WIDTH = D_MODEL - ATT_WIDTH
POOL_GROUP_DIM = POOL_WIDTH // POOL_GROUPS
POOL_WINDOWS = (2, 4, 8, 16)
MIX_WIDTH = ATT_WIDTH + POOL_WIDTH
IN_WIDTH = 3 * ATT_WIDTH + POOL_WIDTH
DILATED_BRANCHES = ((128, 1), (512, 4), (2048, 16))
ROT_DIM = HEAD_DIM // 4
ROPE_THETA = 500000.0
N_EXPERT_GROUPS = 4
EXPERTS_PER_GROUP = 4
N_EXPERTS = N_EXPERT_GROUPS * EXPERTS_PER_GROUP
TOP_K_IN_GROUP = 2
D_EXPERT = D_MODEL // 4
RMS_EPS = 1e-6
NEG_INF = -1e30

kernel_name = "hybrid_dilated_attn_pool_hiermoe"


def rms_norm(x, g):
    x32 = x.astype(jnp.float32)
    y = x32 * lax.rsqrt(jnp.mean(x32 * x32, axis=-1, keepdims=True) + RMS_EPS)
    return (y * g.astype(jnp.float32)).astype(x.dtype)


def rope_tables(seq):
    inv_freq = ROPE_THETA ** (-jnp.arange(0, ROT_DIM, 2, dtype=jnp.float32) / ROT_DIM)
    ang = jnp.arange(seq, dtype=jnp.float32)[:, None] * inv_freq[None, :]
    return jnp.cos(ang), jnp.sin(ang)


def apply_partial_rope(t, cos, sin):
    half = ROT_DIM // 2
    t1, t2, rest = t[..., :half], t[..., half:ROT_DIM], t[..., ROT_DIM:]
    c = cos[None, :, None, :]
    s = sin[None, :, None, :]
    return jnp.concatenate([t1 * c - t2 * s, t2 * c + t1 * s, rest], axis=-1)


def dilated_branch(q, k, v, window, dilation):
    B, S, H, Dh = q.shape
    span = window // dilation
    blk = span
    unit = dilation * blk
    P = -(-S // unit) * unit
    L = P // dilation
    nb = L // blk

    def split(t):
        t = jnp.pad(t, ((0, 0), (0, P - S), (0, 0), (0, 0)))
        t = t.reshape(B, L, dilation, H, Dh).transpose(0, 2, 3, 1, 4)
        return t.reshape(B, dilation, H, nb, blk, Dh)

    qb, kb, vb = split(q), split(k), split(v)
    pad_prev = ((0, 0), (0, 0), (0, 0), (1, 0), (0, 0), (0, 0))
    kcat = jnp.concatenate([jnp.pad(kb, pad_prev)[:, :, :, :-1], kb], axis=4)
    vcat = jnp.concatenate([jnp.pad(vb, pad_prev)[:, :, :, :-1], vb], axis=4)

    qi = jnp.arange(blk)[:, None]
    kj = jnp.arange(2 * blk)[None, :]
    dist = blk + qi - kj
    band = (dist >= 0) & (dist <= span)
    has_prev = (jnp.arange(nb) > 0)[:, None, None] | (kj >= blk)[None]
    mask = band[None] & has_prev

    s = jnp.einsum('brhnqc,brhnkc->brhnqk', qb, kcat)
    s = jnp.where(mask, s, NEG_INF)
    m = jnp.max(s, axis=-1, keepdims=True)
    p = jnp.exp(s - m)
    den = jnp.sum(p, axis=-1, keepdims=True)
    num = jnp.einsum('brhnqk,brhnkc->brhnqc', p, vcat)

    def merge(t):
        X = t.shape[-1]
        t = t.reshape(B, dilation, H, L, X).transpose(0, 3, 1, 2, 4)
        return t.reshape(B, P, H, X)[:, :S]

    return merge(num), merge(m), merge(den)


def dilated_attention(q, k, v):
    outs = [dilated_branch(q, k, v, w, d) for (w, d) in DILATED_BRANCHES]
    m_all = jnp.max(jnp.stack([o[1] for o in outs], axis=0), axis=0)
    num = sum(jnp.exp(o[1] - m_all) * o[0] for o in outs)
    den = sum(jnp.exp(o[1] - m_all) * o[2] for o in outs)
    return num / den


def pool_mixer(u, w_pool, pool_scale):
    B, S, _ = u.shape
    ug = u.astype(jnp.float32).reshape(B, S, POOL_GROUPS, POOL_GROUP_DIM)
    cs = jnp.cumsum(ug, axis=1)
    t1 = jnp.arange(1, S + 1, dtype=jnp.float32)
    outs = []
    for gi, w in enumerate(POOL_WINDOWS):
        c = cs[:, :, gi]
        lower = jnp.pad(c, ((0, 0), (w, 0), (0, 0)))[:, :S]
        cnt = jnp.minimum(t1, float(w))[None, :, None]
        outs.append((c - lower) / cnt - ug[:, :, gi])
    r = jnp.stack(outs, axis=2)
    y = jnp.einsum('bsgc,gce->bsge', r, w_pool.astype(jnp.float32)).reshape(B, S, POOL_WIDTH)
    return (y * pool_scale.astype(jnp.float32)).astype(u.dtype)


def hier_moe(h, w_group, b_group, w_router, b_router, w_gate, w_up, w_down):
    B, S, D = h.shape
    t = h.reshape(B * S, D)
    g_prob = jax.nn.softmax((t @ w_group + b_group).astype(jnp.float32), axis=-1)
    p_top, g_idx = lax.top_k(g_prob, 1)
    e_logit = (t @ w_router + b_router).astype(jnp.float32).reshape(-1, N_EXPERT_GROUPS, EXPERTS_PER_GROUP)
    g_onehot = jax.nn.one_hot(g_idx[:, 0], N_EXPERT_GROUPS, dtype=jnp.float32)
    e_sel = jnp.einsum('tg,tge->te', g_onehot, e_logit)
    v2, i2 = lax.top_k(e_sel, TOP_K_IN_GROUP)
    w2 = jax.nn.softmax(v2, axis=-1) * p_top
    eid = g_idx * EXPERTS_PER_GROUP + i2
    gates = jnp.sum(jax.nn.one_hot(eid, N_EXPERTS, dtype=jnp.float32) * w2[..., None], axis=1)
    hg = jnp.einsum('td,edf->tef', t, w_gate)
    hu = jnp.einsum('td,edf->tef', t, w_up)
    a = jax.nn.silu(hg) * hu * gates[..., None].astype(t.dtype)
    y = jnp.einsum('tef,efd->td', a, w_down)
    return y.reshape(B, S, D)


def setup_inputs(seed: int = 0) -> dict:
    key = jax.random.key(seed)
    ks = jax.random.split(key, 16)
    f32 = jnp.float32
    nrm = lambda k, shape: jax.random.normal(k, shape, dtype=f32)
    return {
        "x": nrm(ks[0], (BATCH, SEQ, D_MODEL)),
        "norm1_gain": 1.0 + 0.02 * nrm(ks[1], (DEPTH, D_MODEL)),
        "w_in": nrm(ks[2], (DEPTH, D_MODEL, IN_WIDTH)) * D_MODEL ** -0.5,
        "q_norm_gain": 1.0 + 0.02 * nrm(ks[3], (DEPTH, HEAD_DIM)),
        "k_norm_gain": 1.0 + 0.02 * nrm(ks[4], (DEPTH, HEAD_DIM)),
        "w_pool": nrm(ks[5], (DEPTH, POOL_GROUPS, POOL_GROUP_DIM, POOL_GROUP_DIM)) * POOL_GROUP_DIM ** -0.5,
        "pool_scale": 1.0 + 0.02 * nrm(ks[6], (DEPTH, POOL_WIDTH)),
        "w_out": nrm(ks[7], (DEPTH, MIX_WIDTH, D_MODEL)) * MIX_WIDTH ** -0.5,
        "norm2_gain": 1.0 + 0.02 * nrm(ks[8], (DEPTH, D_MODEL)),
        "w_group": nrm(ks[9], (DEPTH, D_MODEL, N_EXPERT_GROUPS)) * D_MODEL ** -0.5,
        "b_group": 0.01 * nrm(ks[10], (DEPTH, N_EXPERT_GROUPS)),
        "w_router": nrm(ks[11], (DEPTH, D_MODEL, N_EXPERTS)) * D_MODEL ** -0.5,
        "b_router": 0.01 * nrm(ks[12], (DEPTH, N_EXPERTS)),
        "w_gate": nrm(ks[13], (DEPTH, N_EXPERTS, D_MODEL, D_EXPERT)) * D_MODEL ** -0.5,
        "w_up": nrm(ks[14], (DEPTH, N_EXPERTS, D_MODEL, D_EXPERT)) * D_MODEL ** -0.5,
        "w_down": nrm(ks[15], (DEPTH, N_EXPERTS, D_EXPERT, D_MODEL)) * D_EXPERT ** -0.5,
    }


def reference(x, norm1_gain, w_in, q_norm_gain, k_norm_gain, w_pool, pool_scale, w_out,
              norm2_gain, w_group, b_group, w_router, b_router, w_gate, w_up, w_down):
    B, S, _ = x.shape
    cos, sin = rope_tables(S)
    scale = HEAD_DIM ** -0.5
    for l in range(DEPTH):
        h = rms_norm(x, norm1_gain[l])
        z = h @ w_in[l]
        q, k, v, u = jnp.split(z, [ATT_WIDTH, 2 * ATT_WIDTH, 3 * ATT_WIDTH], axis=-1)
        q = rms_norm(q.reshape(B, S, N_HEADS, HEAD_DIM), q_norm_gain[l]).astype(jnp.float32)
        k = rms_norm(k.reshape(B, S, N_HEADS, HEAD_DIM), k_norm_gain[l]).astype(jnp.float32)
        q = apply_partial_rope(q, cos, sin) * scale
        k = apply_partial_rope(k, cos, sin)
        v = v.reshape(B, S, N_HEADS, HEAD_DIM).astype(jnp.float32)
        att = dilated_attention(q, k, v).reshape(B, S, ATT_WIDTH).astype(x.dtype)
        pool = pool_mixer(u, w_pool[l], pool_scale[l])
        x = x + jnp.concatenate([att, pool], axis=-1) @ w_out[l]
        x = x + hier_moe(rms_norm(x, norm2_gain[l]), w_group[l], b_group[l], w_router[l], b_router[l],
                         w_gate[l], w_up[l], w_down[l])
    return x
```

```cpp
#include <hip/hip_runtime.h>
#include <cstdint>
#include <cstdio>

#ifndef STAGE
#define STAGE 4
#endif

#define LAS __attribute__((address_space(3)))
#define GAS __attribute__((address_space(1)))
typedef unsigned short bf16_t;
typedef short bf16x8 __attribute__((ext_vector_type(8)));
typedef short s16x4 __attribute__((ext_vector_type(4)));
typedef float f32x4 __attribute__((ext_vector_type(4)));
typedef float f32x2 __attribute__((ext_vector_type(2)));
typedef unsigned u32x4 __attribute__((ext_vector_type(4)));
typedef unsigned u32x2 __attribute__((ext_vector_type(2)));

constexpr int D = 1024, NB = 4, SEQ = 4096, DEPTH = 4, T = NB * SEQ;
constexpr int NH = 8, HD = 64, AW = 512, PW = 512, INW = 2048;
constexpr int NEXP = 16, DE = 256, NBKT = 24, LISTCAP = T;
constexpr float EPS = 1e-6f;
constexpr float QSCALE = 0.125f * 1.4426950408889634f;
constexpr int AROWS = 22528;

constexpr size_t CTL_BAR = 0;
constexpr size_t CTL_CNT = 16384;
constexpr size_t CTL_BYTES = 24576;
constexpr size_t WS_SS0 = CTL_BYTES;
constexpr size_t WS_SSP = WS_SS0 + (size_t)T * 4;
constexpr size_t WS_ROPE = WS_SSP + (size_t)T * 64;
constexpr size_t WS_RSTD2 = WS_ROPE + 4096 * 8 * 8;
constexpr size_t WS_GW = WS_RSTD2 + (size_t)T * 4;
constexpr size_t WS_LIST = WS_GW + (size_t)T * 8;
constexpr size_t WS_WR = WS_LIST + (size_t)NBKT * LISTCAP * 4;
constexpr size_t WS_WIN = WS_WR + (size_t)DEPTH * 32 * D * 2;
constexpr size_t WS_WOUT = WS_WIN + (size_t)DEPTH * INW * D * 2;
constexpr size_t WS_W1 = WS_WOUT + (size_t)DEPTH * D * D * 2;
constexpr size_t WS_W2 = WS_W1 + (size_t)DEPTH * NEXP * 512 * D * 2;
constexpr size_t WS_XB = WS_W2 + (size_t)DEPTH * NEXP * D * DE * 2;
constexpr size_t WS_OB = WS_XB;
constexpr size_t WS_DEN = WS_OB + 3 * (size_t)T * AW * 2;
constexpr size_t WS_Q = WS_DEN + 3 * (size_t)T * NH * 4;
constexpr size_t WS_K = WS_Q + (size_t)T * AW * 2, WS_V = WS_K + (size_t)T * AW * 2, WS_U = WS_V + (size_t)T * AW * 2;
constexpr size_t WS_ABUF = WS_Q;
constexpr size_t WS_MIX = WS_U + (size_t)T * AW * 2;
constexpr size_t WS_END = WS_MIX + (size_t)T * D * 2;
static_assert((size_t)AROWS * 512 * 2 <= 2 * (size_t)T * AW * 2, "abuf fits q|k");
static_assert(WS_END <= 300000000, "workspace");
static_assert(CTL_BYTES % 16 == 0, "memset block");

constexpr int RING_BYTES = 131072, MISC_OFF = RING_BYTES, LDS_BYTES = RING_BYTES + 2048;
constexpr int NTHREADS = 512;

struct Params {
    const float *x, *norm1, *w_in, *qg, *kg, *w_pool, *pool_scale, *w_out, *norm2, *w_group, *b_group, *w_router, *b_router, *w_gate, *w_up, *w_down;
    float* out; unsigned char* ws;
    int ph_lo, ph_hi;
};

__device__ __forceinline__ unsigned cvt_pk_bf16(float lo, float hi) { unsigned r; asm volatile("v_cvt_pk_bf16_f32 %0, %1, %2" : "=v"(r) : "v"(lo), "v"(hi)); return r; }
__device__ __forceinline__ float bf2f(unsigned short b) { return __uint_as_float((unsigned)b << 16); }
__device__ __forceinline__ float bflo(unsigned w) { return __uint_as_float(w << 16); }
__device__ __forceinline__ float bfhi(unsigned w) { return __uint_as_float(w & 0xffff0000u); }

#define XB_TMO      128
#define XB_XCNT(j)  (256  + 64 * (j))
#define XB_XSUB(j)  (1280 + 64 * (j))
#define XB_XGEN(j)  (2304 + 64 * (j))
#define XB_TOP      3328
#define XB_TOPGEN   3392
#define XCD_BAR_WORDS 3456
#define XB_SPIN_CAP (1u << 18)
__device__ __forceinline__ unsigned xb_ld(unsigned* p)              { return __hip_atomic_load(p, __ATOMIC_RELAXED, __HIP_MEMORY_SCOPE_AGENT); }
__device__ __forceinline__ unsigned xb_add(unsigned* p, unsigned v) { return __hip_atomic_fetch_add(p, v, __ATOMIC_RELAXED, __HIP_MEMORY_SCOPE_AGENT); }
__device__ __forceinline__ unsigned xb_xcc_id() { return (unsigned)__builtin_amdgcn_s_getreg((3 << 11) | 20) & 0xFu; }
#define XB_SPIN(cond, bar) do { unsigned _sp = 0; while (cond) { __builtin_amdgcn_s_sleep(1); \
    if ((++_sp & 255u) == 0u) { if (xb_ld(&(bar)[XB_TMO])) break; if (_sp > XB_SPIN_CAP) { atomicAdd(&(bar)[XB_TMO], 1u); break; } } } } while (0)
struct XcdBarrier { unsigned* bar; unsigned x; volatile LAS unsigned* st; };
__device__ __forceinline__ XcdBarrier xcd_barrier_post(unsigned* bar, volatile LAS unsigned* st) {
    XcdBarrier b; b.bar = bar; b.x = xb_xcc_id(); b.st = st;
    if (threadIdx.x == 0) (void)xb_add(&bar[XB_XCNT(b.x)], 1u);
    return b;
}
__device__ __forceinline__ void xcd_barrier_complete(unsigned* bar, unsigned x, unsigned& nloc, unsigned& nx) {
    const unsigned G = gridDim.x * gridDim.y * gridDim.z;
    unsigned sum, cnt, mine, sp = 0u;
    for (;;) {
        sum = 0u; cnt = 0u; mine = 0u;
#pragma unroll
        for (unsigned j = 0; j < 16; ++j) { const unsigned c = xb_ld(&bar[XB_XCNT(j)]); sum += c; cnt += (c > 0u) ? 1u : 0u; mine = (j == x) ? c : mine; }
        if (sum == G) break;
        __builtin_amdgcn_s_sleep(1);
        if ((++sp & 255u) == 0u) { if (xb_ld(&bar[XB_TMO])) break; if (sp > XB_SPIN_CAP) { atomicAdd(&bar[XB_TMO], 1u); break; } }
    }
    nloc = mine > 0u ? mine : 1u; nx = cnt > 0u ? cnt : 1u;
}
__device__ __forceinline__ void xcd_barrier(const XcdBarrier& b) {
    asm volatile("s_waitcnt vmcnt(0)" ::: "memory");
    __syncthreads();
    if (threadIdx.x == 0) {
        unsigned* bar = b.bar;
        __builtin_amdgcn_s_waitcnt(0);
        unsigned nloc = b.st[0], nx = b.st[1];
        if (nloc == 0u) { xcd_barrier_complete(bar, b.x, nloc, nx); b.st[0] = nloc; b.st[1] = nx; }
        const unsigned old = xb_add(&bar[XB_XSUB(b.x)], 1u);
        const unsigned gen = old / nloc;
        if (old + 1u == (gen + 1u) * nloc) {
            __builtin_amdgcn_fence(__ATOMIC_RELEASE, "agent");
            asm volatile("s_waitcnt vmcnt(0)" ::: "memory");
            const unsigned og = xb_add(&bar[XB_TOP], 1u);
            const unsigned tg = og / nx;
            if (og + 1u == (tg + 1u) * nx) xb_add(&bar[XB_TOPGEN], 1u);
            else XB_SPIN(xb_ld(&bar[XB_TOPGEN]) == tg, bar);
            __builtin_amdgcn_fence(__ATOMIC_ACQUIRE, "agent");
            xb_add(&bar[XB_XGEN(b.x)], 1u);
            asm volatile("s_waitcnt vmcnt(0)" ::: "memory");
        } else {
            XB_SPIN(xb_ld(&bar[XB_XGEN(b.x)]) == gen, bar);
            __builtin_amdgcn_fence(__ATOMIC_ACQUIRE, "agent");
            asm volatile("s_waitcnt vmcnt(0)" ::: "memory");
        }
    }
    __syncthreads();
}

__host__ __device__ __forceinline__ int win_phys_row(int n) {
    const int pn = n >> 8, c = n & 255, wc = c >> 6, fq = (c >> 4) & 3, bj = (c >> 3) & 1, nn = (c >> 2) & 1, e = c & 3;
    return pn * 256 + 128 * bj + 32 * wc + 16 * nn + 4 * fq + e;
}
constexpr int TCONV_PER_LAYER = 512 + 128 + 3 * 1024;
__device__ __forceinline__ void pro_tconv(const Params& P, int item, LAS float* tile, int tid) {
    const int l = item / TCONV_PER_LAYER; int r = item % TCONV_PER_LAYER;
    const float* src; int ld; const float* scale = nullptr; int k0, n0, kind, e = 0;
    if (r < 512) { kind = 0; src = P.w_in + (size_t)l * D * INW; ld = INW; scale = P.norm1 + l * D; k0 = (r >> 5) * 64; n0 = (r & 31) * 64; }
    else if (r < 640) { r -= 512; kind = 1; src = P.w_out + (size_t)l * D * D; ld = D; k0 = (r >> 4) * 64; n0 = (r & 15) * 64; }
    else if (r < 1664) { r -= 640; kind = 2; e = r >> 6; r &= 63; src = P.w_gate + (size_t)(l * NEXP + e) * D * DE; ld = DE; scale = P.norm2 + l * D; k0 = (r >> 2) * 64; n0 = (r & 3) * 64; }
    else if (r < 2688) { r -= 1664; kind = 3; e = r >> 6; r &= 63; src = P.w_up + (size_t)(l * NEXP + e) * D * DE; ld = DE; scale = P.norm2 + l * D; k0 = (r >> 2) * 64; n0 = (r & 3) * 64; }
    else { r -= 2688; kind = 4; e = r >> 6; r &= 63; src = P.w_down + (size_t)(l * NEXP + e) * DE * D; ld = D; k0 = (r >> 4) * 64; n0 = (r & 15) * 64; }
#pragma unroll
    for (int i = 0; i < 8; ++i) { const int idx = tid + 512 * i, kk = idx >> 6, nn = idx & 63; float v = src[(size_t)(k0 + kk) * ld + n0 + nn]; if (scale) v *= scale[k0 + kk]; tile[kk * 65 + nn] = v; }
    __syncthreads();
    const int nn = tid >> 3, kc = (tid & 7) * 8, n = n0 + nn;
    bf16_t* drow;
    if (kind == 0) drow = (bf16_t*)(P.ws + WS_WIN) + ((size_t)l * INW + win_phys_row(n)) * D;
    else if (kind == 1) drow = (bf16_t*)(P.ws + WS_WOUT) + ((size_t)l * D + n) * D;
    else if (kind == 2) drow = (bf16_t*)(P.ws + WS_W1) + ((size_t)(l * NEXP + e) * 512 + (n >> 7) * 256 + (n & 127)) * D;
    else if (kind == 3) drow = (bf16_t*)(P.ws + WS_W1) + ((size_t)(l * NEXP + e) * 512 + (n >> 7) * 256 + 128 + (n & 127)) * D;
    else drow = (bf16_t*)(P.ws + WS_W2) + ((size_t)(l * NEXP + e) * D + n) * DE;
    u32x4 o;
    o.x = cvt_pk_bf16(tile[(kc + 0) * 65 + nn], tile[(kc + 1) * 65 + nn]); o.y = cvt_pk_bf16(tile[(kc + 2) * 65 + nn], tile[(kc + 3) * 65 + nn]);
    o.z = cvt_pk_bf16(tile[(kc + 4) * 65 + nn], tile[(kc + 5) * 65 + nn]); o.w = cvt_pk_bf16(tile[(kc + 6) * 65 + nn], tile[(kc + 7) * 65 + nn]);
    *(u32x4*)(drow + k0 + kc) = o;
    __syncthreads();
}
__device__ __forceinline__ void pro_poolfold(const Params& P, int item, int tid) {
    const int l = item >> 6, g = (item >> 4) & 3, n = (item & 15) * 64 + (tid & 63), c0 = __builtin_amdgcn_readfirstlane(tid >> 6);
    float acc[16];
#pragma unroll
    for (int i = 0; i < 16; ++i) acc[i] = 0.f;
    const float* wo = P.w_out + ((size_t)l * D + 512 + 128 * g) * D + n;
    const float* ps = P.pool_scale + l * PW + 128 * g;
    const float* wp = P.w_pool + (size_t)(l * 4 + g) * 128 * 128;
    for (int e = 0; e < 128; ++e) {
        const float w = wo[(size_t)e * D] * ps[e];
#pragma unroll
        for (int i = 0; i < 16; ++i) acc[i] += wp[(c0 + 8 * i) * 128 + e] * w;
    }
    bf16_t* dst = (bf16_t*)(P.ws + WS_WOUT) + ((size_t)l * D + n) * D + 512 + 128 * g + c0;
#pragma unroll
    for (int i = 0; i < 16; ++i) dst[8 * i] = (bf16_t)(cvt_pk_bf16(acc[i], 0.f) & 0xffffu);
}
__device__ __forceinline__ float wave_sum(float v) {
#pragma unroll
    for (int o = 1; o < 64; o <<= 1) v += __shfl_xor(v, o);
    return v;
}
__device__ __forceinline__ void row_to_bf16_ss(const float* xrow, bf16_t* orow, float* ss, int lane) {
    const f32x4* xr = (const f32x4*)xrow + lane;
    f32x4 v[4]; float s = 0.f;
#pragma unroll
    for (int j = 0; j < 4; ++j) { v[j] = xr[64 * j]; s += (v[j].x * v[j].x + v[j].y * v[j].y) + (v[j].z * v[j].z + v[j].w * v[j].w); }
    s = wave_sum(s);
    u32x2* o8 = (u32x2*)orow + lane;
#pragma unroll
    for (int j = 0; j < 4; ++j) { u32x2 w; w.x = cvt_pk_bf16(v[j].x, v[j].y); w.y = cvt_pk_bf16(v[j].z, v[j].w); o8[64 * j] = w; }
    if (lane == 0) *ss = s;
}
__device__ __forceinline__ void phase_prologue(const Params& P, LAS unsigned char* lds) {
    const int tid = threadIdx.x, G = gridDim.x, bid = blockIdx.x;
    LAS float* tile = (LAS float*)lds;
    for (int it = bid; it < DEPTH * TCONV_PER_LAYER; it += G) pro_tconv(P, it, tile, tid);
    for (int it = bid; it < DEPTH * 64; it += G) pro_poolfold(P, it, tid);
    const int gt = bid * NTHREADS + tid, NT = G * NTHREADS;
    for (int i = gt; i < DEPTH * 32 * D; i += NT) {
        const int l = i / (32 * D), row = (i / D) & 31, k = i % D; float v = 0.f;
        if (row < 16) v = P.w_router[((size_t)l * D + k) * 16 + row] * P.norm2[l * D + k];
        else if (row < 20) v = P.w_group[((size_t)l * D + k) * 4 + (row - 16)] * P.norm2[l * D + k];
        ((bf16_t*)(P.ws + WS_WR))[i] = (bf16_t)(cvt_pk_bf16(v, 0.f) & 0xffffu);
    }
    for (int i = gt; i < SEQ * 8; i += NT) {
        const int pos = i >> 3, j = i & 7;
        const float inv = powf(500000.0f, -(float)(2 * j) / 16.0f), ang = (float)pos * inv;
        ((f32x2*)(P.ws + WS_ROPE))[i] = (f32x2){cosf(ang), sinf(ang)};
    }
    const int gw = bid * 8 + (tid >> 6), NGW = G * 8;
    for (int m = gw; m < T; m += NGW) row_to_bf16_ss(P.x + (size_t)m * D, (bf16_t*)(P.ws + WS_XB) + (size_t)m * D, (float*)(P.ws + WS_SS0) + m, tid & 63);
}

namespace gb {
constexpr int BM = 256, BK = 64, HALF = 128, HTB = HALF * BK * 2, NXCD = 8, WGM = 8;
__host__ __device__ __forceinline__ int lds_byte(int r, int c) { const int st = (r >> 4) * 2 + (c >> 5), rr = r & 15, cc = c & 31, ob = rr * 64 + cc * 2; return st * 1024 + (ob ^ (((ob >> 9) & 1) << 5)); }
__host__ __device__ __forceinline__ void stage_rc(int b, int& R, int& C) { const int st = b / 1024, sb = b % 1024, swz = sb ^ (((sb >> 9) & 1) << 5); R = (st >> 1) * 16 + swz / 64; C = (st & 1) * 32 + (swz % 64) / 2; }

struct Unit { unsigned aoff[2][2]; const char* A0; const char* B0; const char* B1; int m0, m1, m2, m3; };

template <class Epi, class Sched>
__device__ __forceinline__ void gemm_phase(LAS unsigned char* lds, const Sched& S, const Epi& E) {
    int tid = threadIdx.x; asm volatile("" : "+v"(tid));
    const int wid = __builtin_amdgcn_readfirstlane(tid >> 6), lane = tid & 63, wr = wid >> 2, wc = wid & 3, fr = lane & 15, fq = lane >> 4;
    const int nt = S.nt, ksw = S.ksw;
    int sR[2], sC[2]; unsigned voffB[2], laneA[2];
#pragma unroll
    for (int i = 0; i < 2; ++i) { stage_rc(tid * 16 + i * 8192, sR[i], sC[i]); voffB[i] = (unsigned)(sR[i] * S.ldb + sC[i]) * 2u; laneA[i] = (unsigned)(sR[i] * S.lda + sC[i]) * 2u; }
    const size_t hstepB = (size_t)HALF * S.ldb * 2, hstepA = (size_t)HALF * S.lda * 2;
    const char* const Abase = S.A;
    const unsigned ldsw = (unsigned)wid * 1024u;
    const int aoff = lds_byte(wr * 64 + fr, fq * 8), boff = lds_byte(wc * 32 + fr, fq * 8);
#define GB_SA(b, h) (((b) * 2 + (h)) * HTB)
#define GB_SB(b, h) ((4 + (b) * 2 + (h)) * HTB)
#define GB_STAGE_A(bufoff, kt, U_, off, h) do { _Pragma("unroll") for (int _i = 0; _i < 2; ++_i) { \
        const char* _p; if constexpr (Sched::GATHER) _p = Abase + (size_t)(kt) * 128 + (off)[h][_i]; else _p = (U_) + (size_t)(kt) * 128 + (size_t)(h) * hstepA + laneA[_i]; \
        __builtin_amdgcn_global_load_lds((const unsigned*)_p, (LAS unsigned*)(lds + (bufoff) + ldsw + _i * 8192), 16, 0, 0); } } while (0)
#define GB_STAGE_B(bufoff, ptr) do { _Pragma("unroll") for (int _i = 0; _i < 2; ++_i) \
        __builtin_amdgcn_global_load_lds((const unsigned*)((ptr) + voffB[_i]), (LAS unsigned*)(lds + (bufoff) + ldsw + _i * 8192), 16, 0, 0); } while (0)
#define GB_LDA(dst, b, h) do { _Pragma("unroll") for (int m = 0; m < 4; ++m) _Pragma("unroll") for (int k = 0; k < 2; ++k) dst[m][k] = *(const LAS bf16x8*)(lds + GB_SA(b, h) + aoff + m * 2048 + k * 1024); } while (0)
#define GB_LDB(dst, b, h) do { _Pragma("unroll") for (int n = 0; n < 2; ++n) _Pragma("unroll") for (int k = 0; k < 2; ++k) dst[n][k] = *(const LAS bf16x8*)(lds + GB_SB(b, h) + boff + n * 2048 + k * 1024); } while (0)
#define GB_MMA(ai, bj, At, Bt) do { __builtin_amdgcn_s_setprio(1); _Pragma("unroll") for (int m = 0; m < 4; ++m) _Pragma("unroll") for (int n = 0; n < 2; ++n) _Pragma("unroll") for (int k = 0; k < 2; ++k) \
        acc[ai][bj][m][n] = __builtin_amdgcn_mfma_f32_16x16x32_bf16(Bt[n][k], At[m][k], acc[ai][bj][m][n], 0, 0, 0); __builtin_amdgcn_s_setprio(0); } while (0)
#define GB_WAIT_V(n) asm volatile("s_waitcnt vmcnt(" #n ")" ::: "memory")
#define GB_WAIT_L(n) asm volatile("s_waitcnt lgkmcnt(" #n ")" ::: "memory")
#define GB_BAR __builtin_amdgcn_s_barrier()
#define GB_SCHED __builtin_amdgcn_sched_barrier(0)
#define GB_BPTR(u, kt) ((kt) < ksw ? (u).B0 + (size_t)(kt) * 128 : (u).B1 + (size_t)((kt) - ksw) * 128)
    Unit cur, nxt; int ui = 0;
    if (!S.next(0, cur, sR, sC)) return;
    f32x4 acc[2][2][4][2];
#pragma unroll
    for (int a = 0; a < 2; ++a)
#pragma unroll
        for (int b = 0; b < 2; ++b)
#pragma unroll
            for (int m = 0; m < 4; ++m)
#pragma unroll
                for (int n = 0; n < 2; ++n) acc[a][b][m][n] = (f32x4){0.f, 0.f, 0.f, 0.f};
    bf16x8 At[4][2], B0[2][2], B1[2][2];
    if constexpr (Sched::GATHER) asm volatile("s_waitcnt vmcnt(0)" :: "v"(cur.aoff[0][0]), "v"(cur.aoff[0][1]), "v"(cur.aoff[1][0]), "v"(cur.aoff[1][1]) : "memory");
    {
        const char* b0 = GB_BPTR(cur, 0); const char* b1 = GB_BPTR(cur, 1);
        GB_STAGE_B(GB_SB(0, 0), b0); GB_STAGE_B(GB_SB(0, 1), b0 + hstepB); GB_STAGE_A(GB_SA(0, 0), 0, cur.A0, cur.aoff, 0); GB_STAGE_A(GB_SA(0, 1), 0, cur.A0, cur.aoff, 1);
        if (wr == 1) GB_BAR;
        GB_WAIT_V(2); GB_BAR;
        GB_STAGE_B(GB_SB(1, 0), b1); GB_STAGE_A(GB_SA(1, 0), 1, cur.A0, cur.aoff, 0); GB_STAGE_B(GB_SB(1, 1), b1 + hstepB);
        GB_WAIT_V(6); GB_BAR;
    }
    for (;;) {
        const bool has_next = S.next(ui + 1, nxt, sR, sC);
        if (!has_next) nxt = cur;
        if constexpr (Sched::GATHER) asm volatile("s_waitcnt vmcnt(0)" :: "v"(nxt.aoff[0][0]), "v"(nxt.aoff[0][1]), "v"(nxt.aoff[1][0]), "v"(nxt.aoff[1][1]) : "memory");
#pragma unroll 1
        for (int t = 0; t < nt; t += 2) {
            const bool last = (t == nt - 2);
            unsigned a2o[2][2];
            if constexpr (Sched::GATHER) {
#pragma unroll
                for (int h = 0; h < 2; ++h)
#pragma unroll
                    for (int i = 0; i < 2; ++i) a2o[h][i] = last ? nxt.aoff[h][i] : cur.aoff[h][i];
            }
            const char* a2p = last ? nxt.A0 : cur.A0;
            const int kt2 = last ? 0 : t + 2, kt3 = last ? 1 : t + 3;
            const char* b2 = last ? GB_BPTR(nxt, 0) : GB_BPTR(cur, t + 2);
            const char* b3 = last ? GB_BPTR(nxt, 1) : GB_BPTR(cur, t + 3);
            GB_LDB(B0, 0, 0); GB_LDB(B1, 0, 1); GB_SCHED; GB_LDA(At, 0, 0); GB_STAGE_A(GB_SA(1, 1), t + 1, cur.A0, cur.aoff, 1);
            GB_WAIT_V(8); GB_WAIT_L(0); GB_BAR; GB_MMA(0, 0, At, B0); GB_MMA(0, 1, At, B1); GB_BAR; GB_SCHED;
            GB_LDA(At, 0, 1); GB_STAGE_B(GB_SB(0, 0), b2); GB_STAGE_B(GB_SB(0, 1), b2 + hstepB); GB_STAGE_A(GB_SA(0, 0), kt2, a2p, a2o, 0);
            GB_WAIT_V(8); GB_WAIT_L(0); GB_BAR; GB_MMA(1, 0, At, B0); GB_MMA(1, 1, At, B1); GB_BAR; GB_SCHED;
            GB_LDB(B0, 1, 0); GB_LDB(B1, 1, 1); GB_SCHED; GB_LDA(At, 1, 0); GB_STAGE_A(GB_SA(0, 1), kt2, a2p, a2o, 1);
            GB_WAIT_V(8); GB_WAIT_L(0); GB_BAR; GB_MMA(0, 0, At, B0); GB_MMA(0, 1, At, B1); GB_BAR; GB_SCHED;
            GB_LDA(At, 1, 1); GB_STAGE_B(GB_SB(1, 0), b3); GB_STAGE_B(GB_SB(1, 1), b3 + hstepB); GB_STAGE_A(GB_SA(1, 0), kt3, a2p, a2o, 0);
            GB_WAIT_V(8); GB_WAIT_L(0); GB_BAR; GB_MMA(1, 0, At, B0); GB_MMA(1, 1, At, B1); GB_BAR; GB_SCHED;
        }
        if (wr == 0) GB_BAR;
        E(acc, cur, wr, wc, fr, fq);
        if (!has_next) break;
#pragma unroll
        for (int a = 0; a < 2; ++a)
#pragma unroll
            for (int b = 0; b < 2; ++b)
#pragma unroll
                for (int m = 0; m < 4; ++m)
#pragma unroll
                    for (int n = 0; n < 2; ++n) acc[a][b][m][n] = (f32x4){0.f, 0.f, 0.f, 0.f};
        cur = nxt; ++ui;
        if (wr == 1) GB_BAR;
    }
    GB_WAIT_V(0);
    GB_BAR;
#undef GB_SA
#undef GB_SB
#undef GB_STAGE_A
#undef GB_STAGE_B
#undef GB_LDA
#undef GB_LDB
#undef GB_MMA
#undef GB_WAIT_V
#undef GB_WAIT_L
#undef GB_BAR
#undef GB_SCHED
#undef GB_BPTR
}

struct SchedDense {
    static constexpr bool GATHER = false;
    const char* A; const char* Bt; int lda, ldb, nt, ksw; int nM, nN, G, c;
    __device__ __forceinline__ bool next(int i, Unit& u, const int (&R)[2], const int (&C)[2]) const {
        const int nwg = nM * nN; const long L = (long)i * G + c; if (L >= nwg) return false;
        int wgid = (int)L; { const int q = nwg / NXCD, r = nwg % NXCD, xcd = wgid % NXCD, off = wgid / NXCD; wgid = (xcd < r ? xcd * (q + 1) : r * (q + 1) + (xcd - r) * q) + off; }
        const int nig = WGM * nN, gid = wgid / nig, fm = gid * WGM, gsz = (nM - fm) < WGM ? (nM - fm) : WGM;
        const int pm = fm + ((wgid % nig) % gsz), pn = (wgid % nig) / gsz;
        u.m0 = pm; u.m1 = pn; u.m2 = 0; u.m3 = 0;
        u.A0 = A + (size_t)pm * BM * lda * 2; u.aoff[0][0] = u.aoff[0][1] = u.aoff[1][0] = u.aoff[1][1] = 0u;
        u.B0 = Bt + (size_t)pn * BM * ldb * 2; u.B1 = u.B0; return true;
    }
};
}

struct EpiInProj {
    const float* ss; int npart; bf16_t* qkvu; const float* qg; const float* kg; const f32x2* rope;
    __device__ __forceinline__ void operator()(const f32x4 (&acc)[2][2][4][2], const gb::Unit& u, int wr, int wc, int fr, int fq) const {
        const int pm = u.m0, pn = u.m1, tt = pn >> 1;
        bf16_t* dst = qkvu + (size_t)tt * T * AW + ((pn & 1) * 4 + wc) * 64 + 16 * fq;
        float g[2][2][4];
        if (tt < 2) { const float* gv = (tt == 0 ? qg : kg) + 16 * fq;
#pragma unroll
            for (int bj = 0; bj < 2; ++bj)
#pragma unroll
                for (int n = 0; n < 2; ++n)
#pragma unroll
                    for (int e = 0; e < 4; ++e) g[bj][n][e] = gv[8 * bj + 4 * n + e]; }
#pragma unroll
        for (int ai = 0; ai < 2; ++ai)
#pragma unroll
            for (int m = 0; m < 4; ++m) {
                const int row = pm * 256 + ai * 128 + wr * 64 + m * 16 + fr;
                float ssum;
                if (npart == 1) ssum = ss[row];
                else { const f32x4* sp = (const f32x4*)(ss + (size_t)row * 16); const f32x4 a = sp[0], b = sp[1], c = sp[2], d = sp[3];
                    ssum = (((a[0] + a[1]) + (a[2] + a[3])) + ((b[0] + b[1]) + (b[2] + b[3]))) + (((c[0] + c[1]) + (c[2] + c[3])) + ((d[0] + d[1]) + (d[2] + d[3]))); }
                const float rstd = rsqrtf(ssum * (1.0f / D) + EPS);
                float v[2][2][4];
#pragma unroll
                for (int bj = 0; bj < 2; ++bj)
#pragma unroll
                    for (int n = 0; n < 2; ++n)
#pragma unroll
                        for (int e = 0; e < 4; ++e) v[bj][n][e] = acc[ai][bj][m][n][e] * rstd;
                if (tt < 2) {
                    float s = 0.f;
#pragma unroll
                    for (int bj = 0; bj < 2; ++bj)
#pragma unroll
                        for (int n = 0; n < 2; ++n)
#pragma unroll
                            for (int e = 0; e < 4; ++e) s += v[bj][n][e] * v[bj][n][e];
                    s += __shfl_xor(s, 16); s += __shfl_xor(s, 32);
                    const float rr = rsqrtf(s * (1.0f / HD) + EPS);
#pragma unroll
                    for (int bj = 0; bj < 2; ++bj)
#pragma unroll
                        for (int n = 0; n < 2; ++n)
#pragma unroll
                            for (int e = 0; e < 4; ++e) v[bj][n][e] *= rr * g[bj][n][e];
                    if (fq == 0) {
                        const f32x2* cs = rope + (size_t)(row & (SEQ - 1)) * 8;
#pragma unroll
                        for (int n = 0; n < 2; ++n)
#pragma unroll
                            for (int e = 0; e < 4; ++e) { const f32x2 c = cs[4 * n + e]; const float t1 = v[0][n][e], t2 = v[1][n][e]; v[0][n][e] = t1 * c.x - t2 * c.y; v[1][n][e] = t2 * c.x + t1 * c.y; }
                    }
                    if (tt == 0) {
#pragma unroll
                        for (int bj = 0; bj < 2; ++bj)
#pragma unroll
                            for (int n = 0; n < 2; ++n)
#pragma unroll
                                for (int e = 0; e < 4; ++e) v[bj][n][e] *= QSCALE;
                    }
                }
                bf16_t* rowp = dst + (size_t)row * AW;
#pragma unroll
                for (int bj = 0; bj < 2; ++bj) { u32x4 w; w.x = cvt_pk_bf16(v[bj][0][0], v[bj][0][1]); w.y = cvt_pk_bf16(v[bj][0][2], v[bj][0][3]); w.z = cvt_pk_bf16(v[bj][1][0], v[bj][1][1]); w.w = cvt_pk_bf16(v[bj][1][2], v[bj][1][3]);
                    *(u32x4*)(rowp + 8 * bj) = w; }
            }
    }
};
struct EpiOutProj {
    const float* xin; float* xout; bf16_t* xb;
    __device__ __forceinline__ void operator()(const f32x4 (&acc)[2][2][4][2], const gb::Unit& u, int wr, int wc, int fr, int fq) const {
        const int pm = u.m0, pn = u.m1;
#pragma unroll
        for (int ai = 0; ai < 2; ++ai)
#pragma unroll
            for (int m = 0; m < 4; ++m) {
                const size_t ro = (size_t)(pm * 256 + ai * 128 + wr * 64 + m * 16 + fr) * D + pn * 256 + wc * 32 + 4 * fq;
#pragma unroll
                for (int bj = 0; bj < 2; ++bj)
#pragma unroll
                    for (int n = 0; n < 2; ++n) { const size_t o = ro + bj * 128 + n * 16; const f32x4 y = *(const f32x4*)(xin + o) + acc[ai][bj][m][n];
                        *(f32x4*)(xout + o) = y; u32x2 w; w.x = cvt_pk_bf16(y[0], y[1]); w.y = cvt_pk_bf16(y[2], y[3]); *(u32x2*)(xb + o) = w; }
            }
    }
};

__device__ __forceinline__ void moe_tables(const unsigned* cnt, LAS int* tb) {
    if (threadIdx.x == 0) { int s = 0; for (int b = 0; b < NBKT; ++b) { const int c = (int)cnt[16 * b]; tb[b] = s; tb[32 + b] = c; s += (c + 255) >> 8; } tb[NBKT] = s; }
    __syncthreads();
}
__device__ __forceinline__ int pair_lo(int p) { return p < 3 ? 0 : (p < 5 ? 1 : 2); }
__device__ __forceinline__ int pair_hi(int p) { return p < 3 ? p + 1 : (p < 5 ? p - 1 : 3); }
template <bool SECOND> struct SchedMoe {
    static constexpr bool GATHER = !SECOND;
    const char* A; const char* Wt; const int* list; const LAS int* tb; int lda, ldb, nt, ksw; int G, c;
    __device__ __forceinline__ bool next(int i, gb::Unit& u, const int (&R)[2], const int (&C)[2]) const {
        const int ntile = __builtin_amdgcn_readfirstlane(tb[NBKT]), U = ntile * 4, Up = (U + 7) & ~7;
        const int L = i * G + c; if (L >= Up) return false;
        const int Lr = (L & 7) * (Up >> 3) + (L >> 3);
        if (Lr >= U) { return next_skip(i, u, R, C); }
        const int rt = Lr >> 2, q = Lr & 3;
        int b = 0;
#pragma unroll 1
        for (int j = 1; j < NBKT; ++j) if (__builtin_amdgcn_readfirstlane(tb[j]) <= rt) b = j;
        const int jt = rt - __builtin_amdgcn_readfirstlane(tb[b]), cntb = __builtin_amdgcn_readfirstlane(tb[32 + b]), valid = cntb - 256 * jt;
        const int grp = b / 6, pr = b % 6, elo = grp * 4 + pair_lo(pr), ehi = grp * 4 + pair_hi(pr);
        u.m0 = b * LISTCAP + 256 * jt;
        u.m1 = valid < 256 ? valid : 256;
        u.m2 = rt * 256;
        u.m3 = q;
        if constexpr (!SECOND) {
#pragma unroll
            for (int h = 0; h < 2; ++h)
#pragma unroll
                for (int j = 0; j < 2; ++j) { const int rr = 128 * h + R[j]; const int tok = rr < u.m1 ? list[u.m0 + rr] : 0; u.aoff[h][j] = (unsigned)(tok * lda + C[j]) * 2u; }
            const int e = (q >> 1) ? ehi : elo;
            u.B0 = Wt + ((size_t)e * 512 + (q & 1) * 256) * ldb * 2; u.B1 = u.B0; u.A0 = A;
        } else {
            u.A0 = A + (size_t)u.m2 * lda * 2; u.aoff[0][0] = u.aoff[0][1] = u.aoff[1][0] = u.aoff[1][1] = 0u;
            u.B0 = Wt + ((size_t)elo * D + q * 256) * ldb * 2; u.B1 = Wt + ((size_t)ehi * D + q * 256) * ldb * 2;
        }
        return true;
    }
    __device__ __forceinline__ bool next_skip(int, gb::Unit& u, const int (&)[2], const int (&)[2]) const { u.m1 = -1; return false; }
};
struct EpiMoe1 {
    const int* list; const float* rstd2; const float* gw; bf16_t* abuf;
    __device__ __forceinline__ void operator()(const f32x4 (&acc)[2][2][4][2], const gb::Unit& u, int wr, int wc, int fr, int fq) const {
        const int q = u.m3, slot = q >> 1, half = q & 1;
#pragma unroll
        for (int ai = 0; ai < 2; ++ai)
#pragma unroll
            for (int m = 0; m < 4; ++m) {
                const int rr = ai * 128 + wr * 64 + m * 16 + fr;
                if (rr < u.m1) {
                    const int tok = list[u.m0 + rr]; const float rs = rstd2[tok], w = gw[2 * tok + slot];
                    bf16_t* rowp = abuf + (size_t)(u.m2 + rr) * 512 + slot * 256 + half * 128 + wc * 32 + 4 * fq;
#pragma unroll
                    for (int n = 0; n < 2; ++n) { float a[4];
#pragma unroll
                        for (int e = 0; e < 4; ++e) { const float gg = acc[ai][0][m][n][e] * rs, uu = acc[ai][1][m][n][e] * rs; a[e] = gg / (1.0f + __expf(-gg)) * uu * w; }
                        u32x2 o; o.x = cvt_pk_bf16(a[0], a[1]); o.y = cvt_pk_bf16(a[2], a[3]); *(u32x2*)(rowp + 16 * n) = o; }
                }
            }
    }
};
struct EpiMoe2 {
    const int* list; float* x; bf16_t* xb; float* ssn;
    __device__ __forceinline__ void operator()(const f32x4 (&acc)[2][2][4][2], const gb::Unit& u, int wr, int wc, int fr, int fq) const {
        const int pn = u.m3;
#pragma unroll
        for (int ai = 0; ai < 2; ++ai)
#pragma unroll
            for (int m = 0; m < 4; ++m) {
                const int rr = ai * 128 + wr * 64 + m * 16 + fr; const bool ok = rr < u.m1;
                const int tok = ok ? list[u.m0 + rr] : 0; float s = 0.f;
                if (ok) {
                    const size_t ro = (size_t)tok * D + pn * 256 + wc * 32 + 4 * fq;
#pragma unroll
                    for (int bj = 0; bj < 2; ++bj)
#pragma unroll
                        for (int n = 0; n < 2; ++n) { const size_t o = ro + bj * 128 + n * 16; const f32x4 y = *(const f32x4*)(x + o) + acc[ai][bj][m][n];
                            *(f32x4*)(x + o) = y; u32x2 w; w.x = cvt_pk_bf16(y[0], y[1]); w.y = cvt_pk_bf16(y[2], y[3]); *(u32x2*)(xb + o) = w;
                            s += (y[0] * y[0] + y[1] * y[1]) + (y[2] * y[2] + y[3] * y[3]); }
                }
                s += __shfl_xor(s, 16); s += __shfl_xor(s, 32);
                if (ok && fq == 0) ssn[(size_t)tok * 16 + pn * 4 + wc] = s;
                if (m & 1) asm volatile("" ::: "memory");
            }
    }
};

__device__ __forceinline__ void phase_attn(const Params& P, LAS unsigned char* lds) {
    int tid = threadIdx.x; asm volatile("" : "+v"(tid));
    const int wid = __builtin_amdgcn_readfirstlane(tid >> 6), lane = tid & 63, fr = lane & 15, g = lane >> 4;
    const bf16_t* Q = (const bf16_t*)(P.ws + WS_Q); const bf16_t* K = (const bf16_t*)(P.ws + WS_K); const bf16_t* V = (const bf16_t*)(P.ws + WS_V);
    bf16_t* OB = (bf16_t*)(P.ws + WS_OB); float* DEN = (float*)(P.ws + WS_DEN);
    LAS unsigned char* Kt = lds; LAS unsigned char* Vt = lds + 32768;
    for (int ui = blockIdx.x; ui < NB * NH * 96; ui += gridDim.x) {
        const int bh = ui / 96, rem = ui % 96, br = rem >> 5, idx = rem & 31;
        const int d = br == 0 ? 1 : (br == 1 ? 4 : 16), r = br == 0 ? 0 : (br == 1 ? idx >> 3 : idx >> 1), chunk = br == 0 ? idx : (br == 1 ? idx & 7 : idx & 1);
        const int n0 = chunk * 128, b = bh >> 3, h = bh & 7, tok0 = b * SEQ;
        {
            const int rr = tid >> 1, hf = tid & 1; int n = n0 - 128 + rr; n = n < 0 ? 0 : n;
            const size_t go = ((size_t)(tok0 + d * n + r) * AW + h * HD) * 2 + hf * 64;
            const u32x4* ks = (const u32x4*)((const char*)K + go); const u32x4* vs = (const u32x4*)((const char*)V + go);
            u32x4 kv[4], vv[4];
#pragma unroll
            for (int i = 0; i < 4; ++i) { kv[i] = ks[i]; vv[i] = vs[i]; }
#pragma unroll
            for (int i = 0; i < 4; ++i) { const int ch = 4 * hf + i;
                *(LAS u32x4*)(Kt + rr * 128 + ((ch ^ (rr & 7)) << 4)) = kv[i];
                *(LAS u32x4*)(Vt + rr * 128 + (ch << 4)) = vv[i]; }
        }
        __syncthreads();
        {
            const int nq = n0 + 16 * wid + fr;
            const bf16_t* qp = Q + (size_t)(tok0 + d * nq + r) * AW + h * HD + 8 * g;
            const bf16x8 q0 = *(const bf16x8*)qp, q1 = *(const bf16x8*)(qp + 32);
            f32x4 S[9];
#pragma unroll
            for (int jb = 0; jb < 9; ++jb) {
                const int row = 16 * wid + 16 * jb + fr;
                const bf16x8 k0 = *(const LAS bf16x8*)(Kt + row * 128 + ((g ^ (row & 7)) << 4));
                const bf16x8 k1 = *(const LAS bf16x8*)(Kt + row * 128 + (((4 + g) ^ (row & 7)) << 4));
                f32x4 s = (f32x4){0.f, 0.f, 0.f, 0.f};
                s = __builtin_amdgcn_mfma_f32_16x16x32_bf16(k0, q0, s, 0, 0, 0);
                s = __builtin_amdgcn_mfma_f32_16x16x32_bf16(k1, q1, s, 0, 0, 0);
                S[jb] = s;
            }
            float den = 0.f;
            const int jmin = n0 == 0 ? 8 - wid : 0;
#pragma unroll
            for (int jb = 0; jb < 9; ++jb)
#pragma unroll
                for (int e = 0; e < 4; ++e) {
                    const int ki = 4 * g + e;
                    bool ok = jb >= jmin;
                    if (jb == 0) ok = ok && (ki >= fr);
                    if (jb == 8) ok = ok && (ki <= fr);
                    const float p = ok ? __builtin_amdgcn_exp2f(fminf(S[jb][e], 80.f)) : 0.f;
                    S[jb][e] = p; den += p;
                }
            den += __shfl_xor(den, 16); den += __shfl_xor(den, 32);
            f32x4 O[4];
#pragma unroll
            for (int c = 0; c < 4; ++c) O[c] = (f32x4){0.f, 0.f, 0.f, 0.f};
#pragma unroll
            for (int ks = 0; ks < 5; ++ks) {
                u32x4 pw; pw.x = cvt_pk_bf16(S[2 * ks][0], S[2 * ks][1]); pw.y = cvt_pk_bf16(S[2 * ks][2], S[2 * ks][3]);
                if (ks < 4) { pw.z = cvt_pk_bf16(S[2 * ks + 1][0], S[2 * ks + 1][1]); pw.w = cvt_pk_bf16(S[2 * ks + 1][2], S[2 * ks + 1][3]); } else { pw.z = 0u; pw.w = 0u; }
                const bf16x8 pa = __builtin_bit_cast(bf16x8, pw);
                const int row0 = 16 * wid + 32 * ks + 4 * g + (fr >> 2), row1 = ks < 4 ? row0 + 16 : row0;
#pragma unroll
                for (int c = 0; c < 4; ++c) {
                    const s16x4 v0 = __builtin_bit_cast(s16x4, __builtin_amdgcn_ds_read_tr16_b64_v4i16((LAS s16x4*)(Vt + row0 * 128 + 32 * c + 8 * (fr & 3))));
                    const s16x4 v1 = __builtin_bit_cast(s16x4, __builtin_amdgcn_ds_read_tr16_b64_v4i16((LAS s16x4*)(Vt + row1 * 128 + 32 * c + 8 * (fr & 3))));
                    const bf16x8 vb = (bf16x8){v0[0], v0[1], v0[2], v0[3], v1[0], v1[1], v1[2], v1[3]};
                    O[c] = __builtin_amdgcn_mfma_f32_16x16x32_bf16(pa, vb, O[c], 0, 0, 0);
                }
            }
#pragma unroll
            for (int e = 0; e < 4; ++e) {
                const int tq = tok0 + d * (n0 + 16 * wid + 4 * g + e) + r;
                bf16_t* op = OB + ((size_t)br * T + tq) * AW + h * HD + fr;
#pragma unroll
                for (int c = 0; c < 4; ++c) op[16 * c] = (bf16_t)(cvt_pk_bf16(O[c][e], 0.f) & 0xffffu);
            }
            if (g == 0) DEN[((size_t)br * T + tok0 + d * nq + r) * NH + h] = den;
        }
        __syncthreads();
    }
}
__device__ __forceinline__ void phase_merge(const Params& P) {
    const bf16_t* OB = (const bf16_t*)(P.ws + WS_OB); const float* DEN = (const float*)(P.ws + WS_DEN); const bf16_t* U = (const bf16_t*)(P.ws + WS_U);
    bf16_t* MIX = (bf16_t*)(P.ws + WS_MIX);
    int tid = threadIdx.x; asm volatile("" : "+v"(tid));
    const int gt = blockIdx.x * NTHREADS + tid, NT = gridDim.x * NTHREADS;
    for (int it = gt; it < T * 128; it += NT) {
        const int t = it >> 7, c8 = it & 127;
        float o[8];
        if (c8 < 64) {
            const int h = c8 >> 3; float den = 0.f;
#pragma unroll
            for (int j = 0; j < 8; ++j) o[j] = 0.f;
#pragma unroll
            for (int br = 0; br < 3; ++br) {
                const u32x4 w = *(const u32x4*)(OB + ((size_t)br * T + t) * AW + c8 * 8);
                den += DEN[((size_t)br * T + t) * NH + h];
                o[0] += bflo(w.x); o[1] += bfhi(w.x); o[2] += bflo(w.y); o[3] += bfhi(w.y); o[4] += bflo(w.z); o[5] += bfhi(w.z); o[6] += bflo(w.w); o[7] += bfhi(w.w);
            }
            const float inv = 1.0f / den;
#pragma unroll
            for (int j = 0; j < 8; ++j) o[j] *= inv;
        } else {
            const int cc = (c8 - 64) * 8, gidx = cc >> 7, w = 2 << gidx, s = t & (SEQ - 1); const int cnt = (s + 1) < w ? (s + 1) : w;
            float own[8];
#pragma unroll
            for (int j = 0; j < 8; ++j) o[j] = 0.f;
            for (int jj = 0; jj < cnt; ++jj) {
                const u32x4 wv = *(const u32x4*)(U + (size_t)(t - jj) * PW + cc);
                const float v[8] = {bflo(wv.x), bfhi(wv.x), bflo(wv.y), bfhi(wv.y), bflo(wv.z), bfhi(wv.z), bflo(wv.w), bfhi(wv.w)};
#pragma unroll
                for (int j = 0; j < 8; ++j) { o[j] += v[j]; if (jj == 0) own[j] = v[j]; }
            }
            const float inv = 1.0f / (float)cnt;
#pragma unroll
            for (int j = 0; j < 8; ++j) o[j] = o[j] * inv - own[j];
        }
        u32x4 w; w.x = cvt_pk_bf16(o[0], o[1]); w.y = cvt_pk_bf16(o[2], o[3]); w.z = cvt_pk_bf16(o[4], o[5]); w.w = cvt_pk_bf16(o[6], o[7]);
        *(u32x4*)(MIX + (size_t)t * D + c8 * 8) = w;
    }
}

__device__ __forceinline__ void phase_route(const Params& P, int l, LAS unsigned char* lds) {
    int tid = threadIdx.x; asm volatile("" : "+v"(tid));
    const int wid = __builtin_amdgcn_readfirstlane(tid >> 6), lane = tid & 63, fr = lane & 15, g = lane >> 4;
    LAS int* hist = (LAS int*)(lds + MISC_OFF); LAS int* base = hist + 32;
    const bf16_t* xb = (const bf16_t*)(P.ws + WS_XB); const bf16_t* wr = (const bf16_t*)(P.ws + WS_WR) + (size_t)l * 32 * D;
    unsigned* cnt = (unsigned*)(P.ws + CTL_CNT) + l * NBKT * 16;
    int* list = (int*)(P.ws + WS_LIST); float* gwp = (float*)(P.ws + WS_GW); float* rstd2 = (float*)(P.ws + WS_RSTD2);
    for (int blk = blockIdx.x; blk < T / 64; blk += gridDim.x) {
        if (tid < 32) hist[tid] = 0;
        __syncthreads();
        int bucket = -1, lrank = 0, tok = 0; float wlo = 0.f, whi = 0.f, rstd = 0.f;
        if (wid < 4) {
            tok = blk * 64 + wid * 16 + fr;
            const bf16_t* xp = xb + (size_t)tok * D + 8 * g; const bf16_t* a0p = wr + (size_t)fr * D + 8 * g; const bf16_t* a1p = a0p + 16 * D;
            f32x4 acc0 = (f32x4){0.f, 0.f, 0.f, 0.f}, acc1 = acc0; float ssq = 0.f;
#pragma unroll 8
            for (int kk = 0; kk < 32; ++kk) {
                const bf16x8 xv = *(const bf16x8*)(xp + 32 * kk), a0 = *(const bf16x8*)(a0p + 32 * kk), a1 = *(const bf16x8*)(a1p + 32 * kk);
                acc0 = __builtin_amdgcn_mfma_f32_16x16x32_bf16(a0, xv, acc0, 0, 0, 0);
                acc1 = __builtin_amdgcn_mfma_f32_16x16x32_bf16(a1, xv, acc1, 0, 0, 0);
#pragma unroll
                for (int j = 0; j < 8; ++j) { const float f = bf2f((unsigned short)xv[j]); ssq += f * f; }
            }
            ssq += __shfl_xor(ssq, 16); ssq += __shfl_xor(ssq, 32);
            rstd = rsqrtf(ssq * (1.0f / D) + EPS);
            float gl[4];
#pragma unroll
            for (int e = 0; e < 4; ++e) gl[e] = __shfl(acc1[e], fr) * rstd + P.b_group[l * 4 + e];
            int gs = 0; float gm = gl[0];
#pragma unroll
            for (int e = 1; e < 4; ++e) if (gl[e] > gm) { gm = gl[e]; gs = e; }
            float gden = 0.f;
#pragma unroll
            for (int e = 0; e < 4; ++e) gden += __expf(gl[e] - gm);
            const float ptop = 1.0f / gden;
            if (g == gs) {
                float el[4];
#pragma unroll
                for (int e = 0; e < 4; ++e) el[e] = acc0[e] * rstd + P.b_router[l * 16 + 4 * g + e];
                int i1 = 0;
#pragma unroll
                for (int e = 1; e < 4; ++e) if (el[e] > el[i1]) i1 = e;
                int i2 = -1; float v2 = -3.0e38f;
#pragma unroll
                for (int e = 0; e < 4; ++e) if (e != i1 && el[e] > v2) { v2 = el[e]; i2 = e; }
                const float e2 = __expf(v2 - el[i1]), w1 = ptop / (1.0f + e2), w2 = ptop * e2 / (1.0f + e2);
                const int lo = i1 < i2 ? i1 : i2, hi = i1 < i2 ? i2 : i1;
                wlo = i1 < i2 ? w1 : w2; whi = i1 < i2 ? w2 : w1;
                const int pr = lo == 0 ? hi - 1 : (lo == 1 ? hi + 1 : 5);
                bucket = 6 * gs + pr;
                lrank = atomicAdd((int*)&hist[bucket], 1);
            }
        }
        __syncthreads();
        if (tid < NBKT) { const int hc = hist[tid]; base[tid] = hc ? (int)atomicAdd(cnt + 16 * tid, (unsigned)hc) : 0; }
        __syncthreads();
        if (bucket >= 0) {
            list[bucket * LISTCAP + base[bucket] + lrank] = tok;
            gwp[2 * tok] = wlo; gwp[2 * tok + 1] = whi; rstd2[tok] = rstd;
        }
        __syncthreads();
    }
}

constexpr int NPHASE = 1 + 7 * DEPTH;
__global__ void __launch_bounds__(NTHREADS, 2) fwd(Params P) {
    extern __shared__ __attribute__((aligned(16))) unsigned char lds_raw[];
    LAS unsigned char* lds = (LAS unsigned char*)lds_raw;
    const int tid = threadIdx.x, G = gridDim.x, bid = blockIdx.x;
    const int lo = P.ph_lo, hi = P.ph_hi;
    volatile LAS unsigned* bw = (volatile LAS unsigned*)(lds + MISC_OFF + 1024);
    if (tid < 4) bw[tid] = 0u;
    __syncthreads();
    XcdBarrier bar; bar.bar = (unsigned*)(P.ws + CTL_BAR); bar.x = 0; bar.st = bw;
    const bool multi = (hi - lo) > 1;
    if (multi) bar = xcd_barrier_post((unsigned*)(P.ws + CTL_BAR), bw);
#ifndef PHMASK
#define PHMASK 255
#endif
#define IN(k) (lo <= (k) && (k) < hi)
#define SEAM(k) do { if (IN(k) && IN((k) + 1)) xcd_barrier(bar); } while (0)
    if (IN(0) && (PHMASK & 1)) { phase_prologue(P, lds); }
    SEAM(0);
#pragma unroll 1
    for (int l = 0; l < DEPTH; ++l) {
        const int p0 = 1 + 7 * l;
        const float* ss1 = l == 0 ? (const float*)(P.ws + WS_SS0) : (const float*)(P.ws + WS_SSP);
        if (IN(p0) && (PHMASK & 2)) {
            gb::SchedDense S; S.A = (const char*)(P.ws + WS_XB); S.Bt = (const char*)(P.ws + WS_WIN) + (size_t)l * INW * D * 2; S.lda = D; S.ldb = D; S.nt = D / 64; S.ksw = 1 << 20;
            S.nM = T / 256; S.nN = INW / 256; S.G = G; S.c = bid;
            EpiInProj E{ss1, l == 0 ? 1 : 16, (bf16_t*)(P.ws + WS_Q), P.qg + l * HD, P.kg + l * HD, (const f32x2*)(P.ws + WS_ROPE)};
            gb::gemm_phase<EpiInProj, gb::SchedDense>(lds, S, E);
        }
        SEAM(p0);
        if (IN(p0 + 1) && (PHMASK & 4)) phase_attn(P, lds);
        SEAM(p0 + 1);
        if (IN(p0 + 2) && (PHMASK & 8)) phase_merge(P);
        SEAM(p0 + 2);
        if (IN(p0 + 3) && (PHMASK & 16)) {
            gb::SchedDense S; S.A = (const char*)(P.ws + WS_MIX); S.Bt = (const char*)(P.ws + WS_WOUT) + (size_t)l * D * D * 2; S.lda = D; S.ldb = D; S.nt = D / 64; S.ksw = 1 << 20;
            S.nM = T / 256; S.nN = D / 256; S.G = G; S.c = bid;
            EpiOutProj E{l == 0 ? P.x : P.out, P.out, (bf16_t*)(P.ws + WS_XB)};
            gb::gemm_phase<EpiOutProj, gb::SchedDense>(lds, S, E);
        }
        SEAM(p0 + 3);
        if (IN(p0 + 4) && (PHMASK & 32)) phase_route(P, l, lds);
        SEAM(p0 + 4);
        if (IN(p0 + 5) && (PHMASK & 64)) {
            LAS int* tb = (LAS int*)(lds + MISC_OFF + 256);
            moe_tables((const unsigned*)(P.ws + CTL_CNT) + l * NBKT * 16, tb);
            SchedMoe<false> S; S.A = (const char*)(P.ws + WS_XB); S.Wt = (const char*)(P.ws + WS_W1) + (size_t)l * NEXP * 512 * D * 2; S.list = (const int*)(P.ws + WS_LIST); S.tb = tb;
            S.lda = D; S.ldb = D; S.nt = D / 64; S.ksw = 1 << 20; S.G = G; S.c = bid;
            EpiMoe1 E{(const int*)(P.ws + WS_LIST), (const float*)(P.ws + WS_RSTD2), (const float*)(P.ws + WS_GW), (bf16_t*)(P.ws + WS_ABUF)};
            gb::gemm_phase<EpiMoe1, SchedMoe<false>>(lds, S, E);
        }
        SEAM(p0 + 5);
        if (IN(p0 + 6) && (PHMASK & 128)) {
            LAS int* tb = (LAS int*)(lds + MISC_OFF + 256);
            moe_tables((const unsigned*)(P.ws + CTL_CNT) + l * NBKT * 16, tb);
            SchedMoe<true> S; S.A = (const char*)(P.ws + WS_ABUF); S.Wt = (const char*)(P.ws + WS_W2) + (size_t)l * NEXP * D * DE * 2; S.list = (const int*)(P.ws + WS_LIST); S.tb = tb;
            S.lda = 512; S.ldb = DE; S.nt = 512 / 64; S.ksw = 4; S.G = G; S.c = bid;
            EpiMoe2 E{(const int*)(P.ws + WS_LIST), P.out, (bf16_t*)(P.ws + WS_XB), (float*)(P.ws + WS_SSP)};
            gb::gemm_phase<EpiMoe2, SchedMoe<true>>(lds, S, E);
        }
        SEAM(p0 + 6);
    }
#undef IN
#undef SEAM
}

extern "C" void kernel_launch(void* const* d_in, const int* in_sizes, int n_in, void* d_out, int out_size, void* d_ws, size_t ws_size, hipStream_t stream) {
    static int grid = 0;
    if (grid == 0) {
        if (n_in != 16 || out_size != T * D || ws_size < WS_END) { fprintf(stderr, "kernel_launch: unexpected shapes (n_in %d, out %d, ws %zu < %zu); nothing launched\n", n_in, out_size, ws_size, (size_t)WS_END); grid = -1; return; }
        int dev = 0, cus = 0, per_cu = 0;
        if (hipGetDevice(&dev) != hipSuccess || hipDeviceGetAttribute(&cus, hipDeviceAttributeMultiprocessorCount, dev) != hipSuccess) { grid = -1; return; }
        if (hipFuncSetAttribute((const void*)fwd, hipFuncAttributeMaxDynamicSharedMemorySize, LDS_BYTES) != hipSuccess) { fprintf(stderr, "kernel_launch: hipFuncSetAttribute failed\n"); grid = -1; return; }
        if (hipOccupancyMaxActiveBlocksPerMultiprocessor(&per_cu, (const void*)fwd, NTHREADS, LDS_BYTES) != hipSuccess || per_cu < 1) fprintf(stderr, "kernel_launch: occupancy query says %d\n", per_cu);
        (void)hipGetLastError();
        grid = cus;
    }
    if (grid < 0) return;
    (void)hipMemsetAsync(d_ws, 0, CTL_BYTES, stream);
    Params p{};
    p.x = (const float*)d_in[0]; p.norm1 = (const float*)d_in[1]; p.w_in = (const float*)d_in[2]; p.qg = (const float*)d_in[3]; p.kg = (const float*)d_in[4];
    p.w_pool = (const float*)d_in[5]; p.pool_scale = (const float*)d_in[6]; p.w_out = (const float*)d_in[7]; p.norm2 = (const float*)d_in[8];
    p.w_group = (const float*)d_in[9]; p.b_group = (const float*)d_in[10]; p.w_router = (const float*)d_in[11]; p.b_router = (const float*)d_in[12];
    p.w_gate = (const float*)d_in[13]; p.w_up = (const float*)d_in[14]; p.w_down = (const float*)d_in[15];
    p.out = (float*)d_out; p.ws = (unsigned char*)d_ws;
#define RUN(a, b) do { p.ph_lo = (a); p.ph_hi = (b); hipLaunchKernelGGL(fwd, dim3(grid), dim3(NTHREADS), LDS_BYTES, stream, p); } while (0)
#if STAGE == 4
    RUN(0, NPHASE);
#elif STAGE == 3
    for (int ph = 0; ph < NPHASE; ++ph) RUN(ph, ph + 1);
#endif
#undef RUN
}
```

```cpp
#include <hip/hip_runtime.h>
#include <cstdint>
#include <cstdio>

#ifndef STAGE
#define STAGE 4
#endif

#ifndef DUP
#define DUP 0
#endif
#define LAS __attribute__((address_space(3)))
#define GAS __attribute__((address_space(1)))
typedef unsigned short bf16_t;
typedef short bf16x8 __attribute__((ext_vector_type(8)));
typedef short s16x4 __attribute__((ext_vector_type(4)));
typedef float f32x4 __attribute__((ext_vector_type(4)));
typedef float f32x2 __attribute__((ext_vector_type(2)));
typedef unsigned u32x4 __attribute__((ext_vector_type(4)));
typedef unsigned u32x2 __attribute__((ext_vector_type(2)));

constexpr int D = 1024, NB = 4, SEQ = 4096, DEPTH = 4, T = NB * SEQ;
constexpr int NH = 8, HD = 64, AW = 512, PW = 512, INW = 2048;
constexpr int NEXP = 16, DE = 256, NBKT = 24, LISTCAP = T;
constexpr float EPS = 1e-6f;
constexpr float QSCALE = 0.125f * 1.4426950408889634f;
constexpr int AROWS = 22528;

constexpr size_t CTL_BAR = 0;
constexpr size_t CTL_CNT = 16384;
constexpr size_t CTL_BYTES = 24576;
constexpr size_t WS_SS0 = CTL_BYTES;
constexpr size_t WS_SSP = WS_SS0 + (size_t)T * 4;
constexpr size_t WS_ROPE = WS_SSP + (size_t)T * 64;
constexpr size_t WS_RSTD2 = WS_ROPE + 4096 * 8 * 8;
constexpr size_t WS_GW = WS_RSTD2 + (size_t)T * 4;
constexpr size_t WS_LIST = WS_GW + (size_t)T * 8;
constexpr size_t WS_WR = WS_LIST + (size_t)NBKT * LISTCAP * 4;
constexpr size_t WS_WIN = WS_WR + (size_t)DEPTH * 32 * D * 2;
constexpr size_t WS_WOUT = WS_WIN + (size_t)DEPTH * INW * D * 2;
constexpr size_t WS_W1 = WS_WOUT + (size_t)DEPTH * D * D * 2;
constexpr size_t WS_W2 = WS_W1 + (size_t)DEPTH * NEXP * 512 * D * 2;
constexpr size_t WS_XB = WS_W2 + (size_t)DEPTH * NEXP * D * DE * 2;
constexpr size_t OUT_OB = 0;
constexpr size_t OUT_DEN = OUT_OB + 3 * (size_t)T * AW * 2;
static_assert(OUT_DEN + 3 * (size_t)T * NH * 4 <= (size_t)T * D * 4, "partials fit d_out");
constexpr size_t WS_Q = WS_XB + (size_t)T * D * 2;
constexpr size_t WS_K = WS_Q + (size_t)T * AW * 2, WS_V = WS_K + (size_t)T * AW * 2, WS_U = WS_V + (size_t)T * AW * 2;
constexpr size_t WS_ABUF = WS_Q;
constexpr size_t WS_MIX = WS_U + (size_t)T * AW * 2;
constexpr size_t WS_END = WS_MIX + (size_t)T * D * 2;
static_assert((size_t)AROWS * 512 * 2 <= 2 * (size_t)T * AW * 2, "abuf fits q|k");
static_assert(WS_END <= 300000000, "workspace");
static_assert(CTL_BYTES % 16 == 0, "memset block");

constexpr int RING_BYTES = 131072, MISC_OFF = RING_BYTES, LDS_BYTES = RING_BYTES + 2048;
constexpr int NTHREADS = 512;

struct Params {
    const float *x, *norm1, *w_in, *qg, *kg, *w_pool, *pool_scale, *w_out, *norm2, *w_group, *b_group, *w_router, *b_router, *w_gate, *w_up, *w_down;
    float* out; unsigned char* ws;
    int ph_lo, ph_hi;
};

__device__ __forceinline__ unsigned cvt_pk_bf16(float lo, float hi) { unsigned r; asm volatile("v_cvt_pk_bf16_f32 %0, %1, %2" : "=v"(r) : "v"(lo), "v"(hi)); return r; }
__device__ __forceinline__ float bf2f(unsigned short b) { return __uint_as_float((unsigned)b << 16); }
__device__ __forceinline__ float bflo(unsigned w) { return __uint_as_float(w << 16); }
__device__ __forceinline__ float bfhi(unsigned w) { return __uint_as_float(w & 0xffff0000u); }

#define XB_TMO      128
#define XB_XCNT(j)  (256  + 64 * (j))
#define XB_XSUB(j)  (1280 + 64 * (j))
#define XB_XGEN(j)  (2304 + 64 * (j))
#define XB_TOP      3328
#define XB_TOPGEN   3392
#define XCD_BAR_WORDS 3456
#define XB_SPIN_CAP (1u << 18)
__device__ __forceinline__ unsigned xb_ld(unsigned* p)              { return __hip_atomic_load(p, __ATOMIC_RELAXED, __HIP_MEMORY_SCOPE_AGENT); }
__device__ __forceinline__ unsigned xb_add(unsigned* p, unsigned v) { return __hip_atomic_fetch_add(p, v, __ATOMIC_RELAXED, __HIP_MEMORY_SCOPE_AGENT); }
__device__ __forceinline__ unsigned xb_xcc_id() { return (unsigned)__builtin_amdgcn_s_getreg((3 << 11) | 20) & 0xFu; }
#define XB_SPIN(cond, bar) do { unsigned _sp = 0; while (cond) { __builtin_amdgcn_s_sleep(1); \
    if ((++_sp & 255u) == 0u) { if (xb_ld(&(bar)[XB_TMO])) break; if (_sp > XB_SPIN_CAP) { atomicAdd(&(bar)[XB_TMO], 1u); break; } } } } while (0)
struct XcdBarrier { unsigned* bar; unsigned x; volatile LAS unsigned* st; };
__device__ __forceinline__ XcdBarrier xcd_barrier_post(unsigned* bar, volatile LAS unsigned* st) {
    XcdBarrier b; b.bar = bar; b.x = xb_xcc_id(); b.st = st;
    if (threadIdx.x == 0) (void)xb_add(&bar[XB_XCNT(b.x)], 1u);
    return b;
}
__device__ __forceinline__ void xcd_barrier_complete(unsigned* bar, unsigned x, unsigned& nloc, unsigned& nx) {
    const unsigned G = gridDim.x * gridDim.y * gridDim.z;
    unsigned sum, cnt, mine, sp = 0u;
    for (;;) {
        sum = 0u; cnt = 0u; mine = 0u;
#pragma unroll
        for (unsigned j = 0; j < 16; ++j) { const unsigned c = xb_ld(&bar[XB_XCNT(j)]); sum += c; cnt += (c > 0u) ? 1u : 0u; mine = (j == x) ? c : mine; }
        if (sum == G) break;
        __builtin_amdgcn_s_sleep(1);
        if ((++sp & 255u) == 0u) { if (xb_ld(&bar[XB_TMO])) break; if (sp > XB_SPIN_CAP) { atomicAdd(&bar[XB_TMO], 1u); break; } }
    }
    nloc = mine > 0u ? mine : 1u; nx = cnt > 0u ? cnt : 1u;
}
__device__ __forceinline__ void xcd_barrier(const XcdBarrier& b) {
    asm volatile("s_waitcnt vmcnt(0)" ::: "memory");
    __syncthreads();
    if (threadIdx.x == 0) {
        unsigned* bar = b.bar;
        __builtin_amdgcn_s_waitcnt(0);
        unsigned nloc = b.st[0], nx = b.st[1];
        if (nloc == 0u) { xcd_barrier_complete(bar, b.x, nloc, nx); b.st[0] = nloc; b.st[1] = nx; }
        const unsigned old = xb_add(&bar[XB_XSUB(b.x)], 1u);
        const unsigned gen = old / nloc;
        if (old + 1u == (gen + 1u) * nloc) {
            __builtin_amdgcn_fence(__ATOMIC_RELEASE, "agent");
            asm volatile("s_waitcnt vmcnt(0)" ::: "memory");
            const unsigned og = xb_add(&bar[XB_TOP], 1u);
            const unsigned tg = og / nx;
            if (og + 1u == (tg + 1u) * nx) xb_add(&bar[XB_TOPGEN], 1u);
            else XB_SPIN(xb_ld(&bar[XB_TOPGEN]) == tg, bar);
            __builtin_amdgcn_fence(__ATOMIC_ACQUIRE, "agent");
            xb_add(&bar[XB_XGEN(b.x)], 1u);
            asm volatile("s_waitcnt vmcnt(0)" ::: "memory");
        } else {
            XB_SPIN(xb_ld(&bar[XB_XGEN(b.x)]) == gen, bar);
            __builtin_amdgcn_fence(__ATOMIC_ACQUIRE, "agent");
            asm volatile("s_waitcnt vmcnt(0)" ::: "memory");
        }
    }
    __syncthreads();
}

__host__ __device__ __forceinline__ int win_phys_row(int n) {
    const int pn = n >> 8, c = n & 255, wc = c >> 6, fq = (c >> 4) & 3, bj = (c >> 3) & 1, nn = (c >> 2) & 1, e = c & 3;
    return pn * 256 + 128 * bj + 32 * wc + 16 * nn + 4 * fq + e;
}
constexpr int TCONV_PER_LAYER = 512 + 128 + 3 * 1024;
__device__ __forceinline__ void pro_tconv(const Params& P, int item, int lane) {
    const int l = item / TCONV_PER_LAYER; int r = item % TCONV_PER_LAYER;
    const float* src; int ld; const float* scale = nullptr; int k0, n0, kind, e = 0;
    if (r < 512) { kind = 0; src = P.w_in + (size_t)l * D * INW; ld = INW; scale = P.norm1 + l * D; k0 = (r >> 5) * 64; n0 = (r & 31) * 64; }
    else if (r < 640) { r -= 512; kind = 1; src = P.w_out + (size_t)l * D * D; ld = D; k0 = (r >> 4) * 64; n0 = (r & 15) * 64; }
    else if (r < 1664) { r -= 640; kind = 2; e = r >> 6; r &= 63; src = P.w_gate + (size_t)(l * NEXP + e) * D * DE; ld = DE; scale = P.norm2 + l * D; k0 = (r >> 2) * 64; n0 = (r & 3) * 64; }
    else if (r < 2688) { r -= 1664; kind = 3; e = r >> 6; r &= 63; src = P.w_up + (size_t)(l * NEXP + e) * D * DE; ld = DE; scale = P.norm2 + l * D; k0 = (r >> 2) * 64; n0 = (r & 3) * 64; }
    else { r -= 2688; kind = 4; e = r >> 6; r &= 63; src = P.w_down + (size_t)(l * NEXP + e) * DE * D; ld = D; k0 = (r >> 4) * 64; n0 = (r & 15) * 64; }
    const int q = lane & 15, kg = lane >> 4, kb = k0 + 16 * kg;
    const float* sp = src + (size_t)kb * ld + n0 + 4 * q;
    f32x4 v[16];
#pragma unroll
    for (int j = 0; j < 16; ++j) v[j] = *(const f32x4*)(sp + (size_t)j * ld);
    if (scale) {
#pragma unroll
        for (int i = 0; i < 4; ++i) { const f32x4 sc = *(const f32x4*)(scale + kb + 4 * i);
#pragma unroll
            for (int jj = 0; jj < 4; ++jj) v[4 * i + jj] = v[4 * i + jj] * sc[jj]; }
    }
#pragma unroll
    for (int c = 0; c < 4; ++c) {
        const int n = n0 + 4 * q + c;
        bf16_t* drow;
        if (kind == 0) drow = (bf16_t*)(P.ws + WS_WIN) + ((size_t)l * INW + win_phys_row(n)) * D;
        else if (kind == 1) drow = (bf16_t*)(P.ws + WS_WOUT) + ((size_t)l * D + n) * D;
        else if (kind == 2) drow = (bf16_t*)(P.ws + WS_W1) + ((size_t)(l * NEXP + e) * 512 + (n >> 7) * 256 + (n & 127)) * D;
        else if (kind == 3) drow = (bf16_t*)(P.ws + WS_W1) + ((size_t)(l * NEXP + e) * 512 + (n >> 7) * 256 + 128 + (n & 127)) * D;
        else drow = (bf16_t*)(P.ws + WS_W2) + ((size_t)(l * NEXP + e) * D + n) * DE;
        u32x4 w0, w1;
        w0.x = cvt_pk_bf16(v[0][c], v[1][c]); w0.y = cvt_pk_bf16(v[2][c], v[3][c]); w0.z = cvt_pk_bf16(v[4][c], v[5][c]); w0.w = cvt_pk_bf16(v[6][c], v[7][c]);
        w1.x = cvt_pk_bf16(v[8][c], v[9][c]); w1.y = cvt_pk_bf16(v[10][c], v[11][c]); w1.z = cvt_pk_bf16(v[12][c], v[13][c]); w1.w = cvt_pk_bf16(v[14][c], v[15][c]);
        *(u32x4*)(drow + kb) = w0; *(u32x4*)(drow + kb + 8) = w1;
    }
}
__device__ __forceinline__ void pro_poolfold(const Params& P, int item, int tid) {
    const int l = item >> 6, g = (item >> 4) & 3, n = (item & 15) * 64 + (tid & 63), c0 = __builtin_amdgcn_readfirstlane(tid >> 6);
    float acc[16];
#pragma unroll
    for (int i = 0; i < 16; ++i) acc[i] = 0.f;
    const float* wo = P.w_out + ((size_t)l * D + 512 + 128 * g) * D + n;
    const float* ps = P.pool_scale + l * PW + 128 * g;
    const float* wp = P.w_pool + (size_t)(l * 4 + g) * 128 * 128;
    for (int e = 0; e < 128; ++e) {
        const float w = wo[(size_t)e * D] * ps[e];
#pragma unroll
        for (int i = 0; i < 16; ++i) acc[i] += wp[(c0 + 8 * i) * 128 + e] * w;
    }
    bf16_t* dst = (bf16_t*)(P.ws + WS_WOUT) + ((size_t)l * D + n) * D + 512 + 128 * g + c0;
#pragma unroll
    for (int i = 0; i < 16; ++i) dst[8 * i] = (bf16_t)(cvt_pk_bf16(acc[i], 0.f) & 0xffffu);
}
__device__ __forceinline__ float wave_sum(float v) {
#pragma unroll
    for (int o = 1; o < 64; o <<= 1) v += __shfl_xor(v, o);
    return v;
}
__device__ __forceinline__ void row_to_bf16_ss(const float* xrow, bf16_t* orow, float* ss, int lane) {
    const f32x4* xr = (const f32x4*)xrow + lane;
    f32x4 v[4]; float s = 0.f;
#pragma unroll
    for (int j = 0; j < 4; ++j) { v[j] = xr[64 * j]; s += (v[j].x * v[j].x + v[j].y * v[j].y) + (v[j].z * v[j].z + v[j].w * v[j].w); }
    s = wave_sum(s);
    u32x2* o8 = (u32x2*)orow + lane;
#pragma unroll
    for (int j = 0; j < 4; ++j) { u32x2 w; w.x = cvt_pk_bf16(v[j].x, v[j].y); w.y = cvt_pk_bf16(v[j].z, v[j].w); o8[64 * j] = w; }
    if (lane == 0) *ss = s;
}
__device__ __forceinline__ void phase_prologue(const Params& P, LAS unsigned char* lds) {
    const int tid = threadIdx.x, G = gridDim.x, bid = blockIdx.x;
    { const int gw0 = bid * 8 + (tid >> 6), NGW0 = G * 8;
      for (int it = gw0; it < DEPTH * TCONV_PER_LAYER; it += NGW0) pro_tconv(P, it, tid & 63); }
    for (int it = bid; it < DEPTH * 64; it += G) pro_poolfold(P, it, tid);
    const int gt = bid * NTHREADS + tid, NT = G * NTHREADS;
    for (int i = gt; i < DEPTH * 32 * D; i += NT) {
        const int l = i / (32 * D), row = (i / D) & 31, k = i % D; float v = 0.f;
        if (row < 16) v = P.w_router[((size_t)l * D + k) * 16 + row] * P.norm2[l * D + k];
        else if (row < 20) v = P.w_group[((size_t)l * D + k) * 4 + (row - 16)] * P.norm2[l * D + k];
        ((bf16_t*)(P.ws + WS_WR))[i] = (bf16_t)(cvt_pk_bf16(v, 0.f) & 0xffffu);
    }
    for (int i = gt; i < SEQ * 8; i += NT) {
        const int pos = i >> 3, j = i & 7;
        const float inv = powf(500000.0f, -(float)(2 * j) / 16.0f), ang = (float)pos * inv;
        ((f32x2*)(P.ws + WS_ROPE))[i] = (f32x2){cosf(ang), sinf(ang)};
    }
    const int gw = bid * 8 + (tid >> 6), NGW = G * 8;
    for (int m = gw; m < T; m += NGW) row_to_bf16_ss(P.x + (size_t)m * D, (bf16_t*)(P.ws + WS_XB) + (size_t)m * D, (float*)(P.ws + WS_SS0) + m, tid & 63);
}

namespace gb {
constexpr int BM = 256, BK = 64, HALF = 128, HTB = HALF * BK * 2, NXCD = 8, WGM = 8;
__host__ __device__ __forceinline__ int lds_byte(int r, int c) { const int st = (r >> 4) * 2 + (c >> 5), rr = r & 15, cc = c & 31, ob = rr * 64 + cc * 2; return st * 1024 + (ob ^ (((ob >> 9) & 1) << 5)); }
__host__ __device__ __forceinline__ void stage_rc(int b, int& R, int& C) { const int st = b / 1024, sb = b % 1024, swz = sb ^ (((sb >> 9) & 1) << 5); R = (st >> 1) * 16 + swz / 64; C = (st & 1) * 32 + (swz % 64) / 2; }

struct Unit { unsigned aoff[2][2]; const char* A0; const char* B0; const char* B1; int m0, m1, m2, m3; };

template <class Epi, class Sched>
__device__ __forceinline__ void gemm_phase(LAS unsigned char* lds, const Sched& S, const Epi& E) {
    int tid = threadIdx.x; asm volatile("" : "+v"(tid));
    const int wid = __builtin_amdgcn_readfirstlane(tid >> 6), lane = tid & 63, wr = wid >> 2, wc = wid & 3, fr = lane & 15, fq = lane >> 4;
    const int nt = S.nt, ksw = S.ksw;
    int sR[2], sC[2]; unsigned voffB[2], laneA[2];
#pragma unroll
    for (int i = 0; i < 2; ++i) { stage_rc(tid * 16 + i * 8192, sR[i], sC[i]); voffB[i] = (unsigned)(sR[i] * S.ldb + sC[i]) * 2u; laneA[i] = (unsigned)(sR[i] * S.lda + sC[i]) * 2u; }
    const size_t hstepB = (size_t)HALF * S.ldb * 2, hstepA = (size_t)HALF * S.lda * 2;
    const char* const Abase = S.A;
    const unsigned ldsw = (unsigned)wid * 1024u;
    const int aoff = lds_byte(wr * 64 + fr, fq * 8), boff = lds_byte(wc * 32 + fr, fq * 8);
#define GB_SA(b, h) (((b) * 2 + (h)) * HTB)
#define GB_SB(b, h) ((4 + (b) * 2 + (h)) * HTB)
#define GB_STAGE_A(bufoff, kt, U_, off, h) do { _Pragma("unroll") for (int _i = 0; _i < 2; ++_i) { \
        const char* _p; if constexpr (Sched::GATHER) _p = Abase + (size_t)(kt) * 128 + (off)[h][_i]; else _p = (U_) + (size_t)(kt) * 128 + (size_t)(h) * hstepA + laneA[_i]; \
        __builtin_amdgcn_global_load_lds((const unsigned*)_p, (LAS unsigned*)(lds + (bufoff) + ldsw + _i * 8192), 16, 0, 0); } } while (0)
#define GB_STAGE_B(bufoff, ptr) do { _Pragma("unroll") for (int _i = 0; _i < 2; ++_i) \
        __builtin_amdgcn_global_load_lds((const unsigned*)((ptr) + voffB[_i]), (LAS unsigned*)(lds + (bufoff) + ldsw + _i * 8192), 16, 0, 0); } while (0)
#define GB_LDA(dst, b, h) do { _Pragma("unroll") for (int m = 0; m < 4; ++m) _Pragma("unroll") for (int k = 0; k < 2; ++k) dst[m][k] = *(const LAS bf16x8*)(lds + GB_SA(b, h) + aoff + m * 2048 + k * 1024); } while (0)
#define GB_LDB(dst, b, h) do { _Pragma("unroll") for (int n = 0; n < 2; ++n) _Pragma("unroll") for (int k = 0; k < 2; ++k) dst[n][k] = *(const LAS bf16x8*)(lds + GB_SB(b, h) + boff + n * 2048 + k * 1024); } while (0)
#define GB_MMA(ai, bj, At, Bt) do { __builtin_amdgcn_s_setprio(1); _Pragma("unroll") for (int m = 0; m < 4; ++m) _Pragma("unroll") for (int n = 0; n < 2; ++n) _Pragma("unroll") for (int k = 0; k < 2; ++k) \
        acc[ai][bj][m][n] = __builtin_amdgcn_mfma_f32_16x16x32_bf16(Bt[n][k], At[m][k], acc[ai][bj][m][n], 0, 0, 0); __builtin_amdgcn_s_setprio(0); } while (0)
#define GB_WAIT_V(n) asm volatile("s_waitcnt vmcnt(" #n ")" ::: "memory")
#define GB_WAIT_L(n) asm volatile("s_waitcnt lgkmcnt(" #n ")" ::: "memory")
#define GB_BAR __builtin_amdgcn_s_barrier()
#define GB_SCHED __builtin_amdgcn_sched_barrier(0)
#define GB_BPTR(u, kt) ((kt) < ksw ? (u).B0 + (size_t)(kt) * 128 : (u).B1 + (size_t)((kt) - ksw) * 128)
    Unit cur, nxt; int ui = 0;
    if (!S.next(0, cur, sR, sC)) return;
    f32x4 acc[2][2][4][2];
#pragma unroll
    for (int a = 0; a < 2; ++a)
#pragma unroll
        for (int b = 0; b < 2; ++b)
#pragma unroll
            for (int m = 0; m < 4; ++m)
#pragma unroll
                for (int n = 0; n < 2; ++n) acc[a][b][m][n] = (f32x4){0.f, 0.f, 0.f, 0.f};
    bf16x8 At[4][2], B0[2][2], B1[2][2];
    if constexpr (Sched::GATHER) asm volatile("s_waitcnt vmcnt(0)" :: "v"(cur.aoff[0][0]), "v"(cur.aoff[0][1]), "v"(cur.aoff[1][0]), "v"(cur.aoff[1][1]) : "memory");
    {
        const char* b0 = GB_BPTR(cur, 0); const char* b1 = GB_BPTR(cur, 1);
        GB_STAGE_B(GB_SB(0, 0), b0); GB_STAGE_B(GB_SB(0, 1), b0 + hstepB); GB_STAGE_A(GB_SA(0, 0), 0, cur.A0, cur.aoff, 0); GB_STAGE_A(GB_SA(0, 1), 0, cur.A0, cur.aoff, 1);
        if (wr == 1) GB_BAR;
        GB_WAIT_V(2); GB_BAR;
        GB_STAGE_B(GB_SB(1, 0), b1); GB_STAGE_A(GB_SA(1, 0), 1, cur.A0, cur.aoff, 0); GB_STAGE_B(GB_SB(1, 1), b1 + hstepB);
        GB_WAIT_V(6); GB_BAR;
    }
    for (;;) {
        const bool has_next = S.next(ui + 1, nxt, sR, sC);
        if (!has_next) nxt = cur;
        if constexpr (Sched::GATHER) asm volatile("s_waitcnt vmcnt(0)" :: "v"(nxt.aoff[0][0]), "v"(nxt.aoff[0][1]), "v"(nxt.aoff[1][0]), "v"(nxt.aoff[1][1]) : "memory");
#pragma unroll 1
        for (int t = 0; t < nt; t += 2) {
            const bool last = (t == nt - 2);
            unsigned a2o[2][2];
            if constexpr (Sched::GATHER) {
#pragma unroll
                for (int h = 0; h < 2; ++h)
#pragma unroll
                    for (int i = 0; i < 2; ++i) a2o[h][i] = last ? nxt.aoff[h][i] : cur.aoff[h][i];
            }
            const char* a2p = last ? nxt.A0 : cur.A0;
            const int kt2 = last ? 0 : t + 2, kt3 = last ? 1 : t + 3;
            const char* b2 = last ? GB_BPTR(nxt, 0) : GB_BPTR(cur, t + 2);
            const char* b3 = last ? GB_BPTR(nxt, 1) : GB_BPTR(cur, t + 3);
            GB_LDB(B0, 0, 0); GB_LDB(B1, 0, 1); GB_SCHED; GB_LDA(At, 0, 0); GB_STAGE_A(GB_SA(1, 1), t + 1, cur.A0, cur.aoff, 1);
            GB_WAIT_V(8); GB_WAIT_L(0); GB_BAR; GB_MMA(0, 0, At, B0); GB_MMA(0, 1, At, B1); GB_BAR; GB_SCHED;
            GB_LDA(At, 0, 1); GB_STAGE_B(GB_SB(0, 0), b2); GB_STAGE_B(GB_SB(0, 1), b2 + hstepB); GB_STAGE_A(GB_SA(0, 0), kt2, a2p, a2o, 0);
            GB_WAIT_V(8); GB_WAIT_L(0); GB_BAR; GB_MMA(1, 0, At, B0); GB_MMA(1, 1, At, B1); GB_BAR; GB_SCHED;
            GB_LDB(B0, 1, 0); GB_LDB(B1, 1, 1); GB_SCHED; GB_LDA(At, 1, 0); GB_STAGE_A(GB_SA(0, 1), kt2, a2p, a2o, 1);
            GB_WAIT_V(8); GB_WAIT_L(0); GB_BAR; GB_MMA(0, 0, At, B0); GB_MMA(0, 1, At, B1); GB_BAR; GB_SCHED;
            GB_LDA(At, 1, 1); GB_STAGE_B(GB_SB(1, 0), b3); GB_STAGE_B(GB_SB(1, 1), b3 + hstepB); GB_STAGE_A(GB_SA(1, 0), kt3, a2p, a2o, 0);
            GB_WAIT_V(8); GB_WAIT_L(0); GB_BAR; GB_MMA(1, 0, At, B0); GB_MMA(1, 1, At, B1); GB_BAR; GB_SCHED;
        }
        if (wr == 0) GB_BAR;
        E(acc, cur, wr, wc, fr, fq);
        if (!has_next) break;
#pragma unroll
        for (int a = 0; a < 2; ++a)
#pragma unroll
            for (int b = 0; b < 2; ++b)
#pragma unroll
                for (int m = 0; m < 4; ++m)
#pragma unroll
                    for (int n = 0; n < 2; ++n) acc[a][b][m][n] = (f32x4){0.f, 0.f, 0.f, 0.f};
        cur = nxt; ++ui;
        if (wr == 1) GB_BAR;
    }
    GB_WAIT_V(0);
    GB_BAR;
#undef GB_SA
#undef GB_SB
#undef GB_STAGE_A
#undef GB_STAGE_B
#undef GB_LDA
#undef GB_LDB
#undef GB_MMA
#undef GB_WAIT_V
#undef GB_WAIT_L
#undef GB_BAR
#undef GB_SCHED
#undef GB_BPTR
}

struct SchedDense {
    static constexpr bool GATHER = false;
    const char* A; const char* Bt; int lda, ldb, nt, ksw; int nM, nN, G, c;
    __device__ __forceinline__ bool next(int i, Unit& u, const int (&R)[2], const int (&C)[2]) const {
        const int nwg = nM * nN; const long L = (long)i * G + c; if (L >= nwg) return false;
        int wgid = (int)L; { const int q = nwg / NXCD, r = nwg % NXCD, xcd = wgid % NXCD, off = wgid / NXCD; wgid = (xcd < r ? xcd * (q + 1) : r * (q + 1) + (xcd - r) * q) + off; }
        const int nig = WGM * nN, gid = wgid / nig, fm = gid * WGM, gsz = (nM - fm) < WGM ? (nM - fm) : WGM;
        const int pm = fm + ((wgid % nig) % gsz), pn = (wgid % nig) / gsz;
        u.m0 = pm; u.m1 = pn; u.m2 = 0; u.m3 = 0;
        u.A0 = A + (size_t)pm * BM * lda * 2; u.aoff[0][0] = u.aoff[0][1] = u.aoff[1][0] = u.aoff[1][1] = 0u;
        u.B0 = Bt + (size_t)pn * BM * ldb * 2; u.B1 = u.B0; return true;
    }
};
}

struct EpiInProj {
    const float* ss; int npart; bf16_t* qkvu; const float* qg; const float* kg; const f32x2* rope;
    __device__ __forceinline__ void operator()(const f32x4 (&acc)[2][2][4][2], const gb::Unit& u, int wr, int wc, int fr, int fq) const {
        const int pm = u.m0, pn = u.m1, tt = pn >> 1;
        bf16_t* dst = qkvu + (size_t)tt * T * AW + ((pn & 1) * 4 + wc) * 64 + 16 * fq;
        float g[2][2][4];
        if (tt < 2) { const float* gv = (tt == 0 ? qg : kg) + 16 * fq;
#pragma unroll
            for (int bj = 0; bj < 2; ++bj)
#pragma unroll
                for (int n = 0; n < 2; ++n)
#pragma unroll
                    for (int e = 0; e < 4; ++e) g[bj][n][e] = gv[8 * bj + 4 * n + e]; }
#pragma unroll
        for (int ai = 0; ai < 2; ++ai)
#pragma unroll
            for (int m = 0; m < 4; ++m) {
                const int row = pm * 256 + ai * 128 + wr * 64 + m * 16 + fr;
                float ssum;
                if (npart == 1) ssum = ss[row];
                else { const f32x4* sp = (const f32x4*)(ss + (size_t)row * 16); const f32x4 a = sp[0], b = sp[1], c = sp[2], d = sp[3];
                    ssum = (((a[0] + a[1]) + (a[2] + a[3])) + ((b[0] + b[1]) + (b[2] + b[3]))) + (((c[0] + c[1]) + (c[2] + c[3])) + ((d[0] + d[1]) + (d[2] + d[3]))); }
                const float rstd = rsqrtf(ssum * (1.0f / D) + EPS);
                float v[2][2][4];
#pragma unroll
                for (int bj = 0; bj < 2; ++bj)
#pragma unroll
                    for (int n = 0; n < 2; ++n)
#pragma unroll
                        for (int e = 0; e < 4; ++e) v[bj][n][e] = acc[ai][bj][m][n][e] * rstd;
                if (tt < 2) {
                    float s = 0.f;
#pragma unroll
                    for (int bj = 0; bj < 2; ++bj)
#pragma unroll
                        for (int n = 0; n < 2; ++n)
#pragma unroll
                            for (int e = 0; e < 4; ++e) s += v[bj][n][e] * v[bj][n][e];
                    s += __shfl_xor(s, 16); s += __shfl_xor(s, 32);
                    const float rr = rsqrtf(s * (1.0f / HD) + EPS);
#pragma unroll
                    for (int bj = 0; bj < 2; ++bj)
#pragma unroll
                        for (int n = 0; n < 2; ++n)
#pragma unroll
                            for (int e = 0; e < 4; ++e) v[bj][n][e] *= rr * g[bj][n][e];
                    if (fq == 0) {
                        const f32x2* cs = rope + (size_t)(row & (SEQ - 1)) * 8;
#pragma unroll
                        for (int n = 0; n < 2; ++n)
#pragma unroll
                            for (int e = 0; e < 4; ++e) { const f32x2 c = cs[4 * n + e]; const float t1 = v[0][n][e], t2 = v[1][n][e]; v[0][n][e] = t1 * c.x - t2 * c.y; v[1][n][e] = t2 * c.x + t1 * c.y; }
                    }
                    if (tt == 0) {
#pragma unroll
                        for (int bj = 0; bj < 2; ++bj)
#pragma unroll
                            for (int n = 0; n < 2; ++n)
#pragma unroll
                                for (int e = 0; e < 4; ++e) v[bj][n][e] *= QSCALE;
                    }
                }
                bf16_t* rowp = dst + (size_t)row * AW;
#pragma unroll
                for (int bj = 0; bj < 2; ++bj) { u32x4 w; w.x = cvt_pk_bf16(v[bj][0][0], v[bj][0][1]); w.y = cvt_pk_bf16(v[bj][0][2], v[bj][0][3]); w.z = cvt_pk_bf16(v[bj][1][0], v[bj][1][1]); w.w = cvt_pk_bf16(v[bj][1][2], v[bj][1][3]);
                    *(u32x4*)(rowp + 8 * bj) = w; }
            }
    }
};
struct EpiNull {
    __device__ __forceinline__ void operator()(const f32x4 (&acc)[2][2][4][2], const gb::Unit&, int, int, int, int) const {
#pragma unroll
        for (int ai = 0; ai < 2; ++ai)
#pragma unroll
            for (int bj = 0; bj < 2; ++bj)
#pragma unroll
                for (int m = 0; m < 4; ++m)
#pragma unroll
                    for (int n = 0; n < 2; ++n) asm volatile("" :: "v"(acc[ai][bj][m][n]));
    }
};
struct EpiOutProj {
    bf16_t* xb;
    __device__ __forceinline__ void operator()(const f32x4 (&acc)[2][2][4][2], const gb::Unit& u, int wr, int wc, int fr, int fq) const {
        const int pm = u.m0, pn = u.m1;
#pragma unroll
        for (int ai = 0; ai < 2; ++ai)
#pragma unroll
            for (int m = 0; m < 4; ++m) {
                const size_t ro = (size_t)(pm * 256 + ai * 128 + wr * 64 + m * 16 + fr) * D + pn * 256 + wc * 32 + 4 * fq;
#pragma unroll
                for (int bj = 0; bj < 2; ++bj)
#pragma unroll
                    for (int n = 0; n < 2; ++n) { const size_t o = ro + bj * 128 + n * 16; const u32x2 xv = *(const u32x2*)(xb + o);
                        const f32x4 a = acc[ai][bj][m][n]; u32x2 w; w.x = cvt_pk_bf16(bflo(xv.x) + a[0], bfhi(xv.x) + a[1]); w.y = cvt_pk_bf16(bflo(xv.y) + a[2], bfhi(xv.y) + a[3]); *(u32x2*)(xb + o) = w; }
            }
    }
};

__device__ __forceinline__ void moe_tables(const unsigned* cnt, LAS int* tb) {
    if (threadIdx.x == 0) { int s = 0; for (int b = 0; b < NBKT; ++b) { const int c = (int)cnt[16 * b]; tb[b] = s; tb[32 + b] = c; s += (c + 255) >> 8; } tb[NBKT] = s; }
    __syncthreads();
}
__device__ __forceinline__ int pair_lo(int p) { return p < 3 ? 0 : (p < 5 ? 1 : 2); }
__device__ __forceinline__ int pair_hi(int p) { return p < 3 ? p + 1 : (p < 5 ? p - 1 : 3); }
template <bool SECOND> struct SchedMoe {
    static constexpr bool GATHER = !SECOND;
    const char* A; const char* Wt; const int* list; const LAS int* tb; int lda, ldb, nt, ksw; int G, c;
    __device__ __forceinline__ bool next(int i, gb::Unit& u, const int (&R)[2], const int (&C)[2]) const {
        const int ntile = __builtin_amdgcn_readfirstlane(tb[NBKT]), U = ntile * 4, Up = (U + 7) & ~7;
        const int L = i * G + c; if (L >= Up) return false;
        const int Lr = (L & 7) * (Up >> 3) + (L >> 3);
        if (Lr >= U) { return next_skip(i, u, R, C); }
        const int rt = Lr >> 2, q = Lr & 3;
        int b = 0;
#pragma unroll 1
        for (int j = 1; j < NBKT; ++j) if (__builtin_amdgcn_readfirstlane(tb[j]) <= rt) b = j;
        const int jt = rt - __builtin_amdgcn_readfirstlane(tb[b]), cntb = __builtin_amdgcn_readfirstlane(tb[32 + b]), valid = cntb - 256 * jt;
        const int grp = b / 6, pr = b % 6, elo = grp * 4 + pair_lo(pr), ehi = grp * 4 + pair_hi(pr);
        u.m0 = b * LISTCAP + 256 * jt;
        u.m1 = valid < 256 ? valid : 256;
        u.m2 = rt * 256;
        u.m3 = q;
        if constexpr (!SECOND) {
#pragma unroll
            for (int h = 0; h < 2; ++h)
#pragma unroll
                for (int j = 0; j < 2; ++j) { const int rr = 128 * h + R[j]; const int tok = rr < u.m1 ? list[u.m0 + rr] : 0; u.aoff[h][j] = (unsigned)(tok * lda + C[j]) * 2u; }
            const int e = (q >> 1) ? ehi : elo;
            u.B0 = Wt + ((size_t)e * 512 + (q & 1) * 256) * ldb * 2; u.B1 = u.B0; u.A0 = A;
        } else {
            u.A0 = A + (size_t)u.m2 * lda * 2; u.aoff[0][0] = u.aoff[0][1] = u.aoff[1][0] = u.aoff[1][1] = 0u;
            u.B0 = Wt + ((size_t)elo * D + q * 256) * ldb * 2; u.B1 = Wt + ((size_t)ehi * D + q * 256) * ldb * 2;
        }
        return true;
    }
    __device__ __forceinline__ bool next_skip(int, gb::Unit& u, const int (&)[2], const int (&)[2]) const { u.m1 = -1; return false; }
};
struct EpiMoe1 {
    const int* list; const float* rstd2; const float* gw; bf16_t* abuf;
    __device__ __forceinline__ void operator()(const f32x4 (&acc)[2][2][4][2], const gb::Unit& u, int wr, int wc, int fr, int fq) const {
        const int q = u.m3, slot = q >> 1, half = q & 1;
#pragma unroll
        for (int ai = 0; ai < 2; ++ai)
#pragma unroll
            for (int m = 0; m < 4; ++m) {
                const int rr = ai * 128 + wr * 64 + m * 16 + fr;
                if (rr < u.m1) {
                    const int tok = list[u.m0 + rr]; const float rs = rstd2[tok], w = gw[2 * tok + slot];
                    bf16_t* rowp = abuf + (size_t)(u.m2 + rr) * 512 + slot * 256 + half * 128 + wc * 32 + 4 * fq;
#pragma unroll
                    for (int n = 0; n < 2; ++n) { float a[4];
#pragma unroll
                        for (int e = 0; e < 4; ++e) { const float gg = acc[ai][0][m][n][e] * rs, uu = acc[ai][1][m][n][e] * rs; a[e] = gg / (1.0f + __expf(-gg)) * uu * w; }
                        u32x2 o; o.x = cvt_pk_bf16(a[0], a[1]); o.y = cvt_pk_bf16(a[2], a[3]); *(u32x2*)(rowp + 16 * n) = o; }
                }
            }
    }
};
struct EpiMoe2 {
    const int* list; float* out; bf16_t* xb; float* ssn;
    __device__ __forceinline__ void operator()(const f32x4 (&acc)[2][2][4][2], const gb::Unit& u, int wr, int wc, int fr, int fq) const {
        const int pn = u.m3;
#pragma unroll
        for (int ai = 0; ai < 2; ++ai)
#pragma unroll
            for (int m = 0; m < 4; ++m) {
                const int rr = ai * 128 + wr * 64 + m * 16 + fr; const bool ok = rr < u.m1;
                const int tok = ok ? list[u.m0 + rr] : 0; float s = 0.f;
                if (ok) {
                    const size_t ro = (size_t)tok * D + pn * 256 + wc * 32 + 4 * fq;
#pragma unroll
                    for (int bj = 0; bj < 2; ++bj)
#pragma unroll
                        for (int n = 0; n < 2; ++n) { const size_t o = ro + bj * 128 + n * 16; const u32x2 xv = *(const u32x2*)(xb + o); const f32x4 a = acc[ai][bj][m][n];
                            const f32x4 y = (f32x4){bflo(xv.x) + a[0], bfhi(xv.x) + a[1], bflo(xv.y) + a[2], bfhi(xv.y) + a[3]};
                            if (out) { *(f32x4*)(out + o) = y; }
                            else { u32x2 w; w.x = cvt_pk_bf16(y[0], y[1]); w.y = cvt_pk_bf16(y[2], y[3]); *(u32x2*)(xb + o) = w;
                                const float r0 = bflo(w.x), r1 = bfhi(w.x), r2 = bflo(w.y), r3 = bfhi(w.y); s += (r0 * r0 + r1 * r1) + (r2 * r2 + r3 * r3); } }
                }
                s += __shfl_xor(s, 16); s += __shfl_xor(s, 32);
                if (!out && ok && fq == 0) ssn[(size_t)tok * 16 + pn * 4 + wc] = s;
            }
    }
};

__device__ __forceinline__ void phase_attn(const Params& P, LAS unsigned char* lds) {
    int tid = threadIdx.x; asm volatile("" : "+v"(tid));
    const int wid = __builtin_amdgcn_readfirstlane(tid >> 6), lane = tid & 63, fr = lane & 15, g = lane >> 4;
    const bf16_t* Q = (const bf16_t*)(P.ws + WS_Q); const bf16_t* K = (const bf16_t*)(P.ws + WS_K); const bf16_t* V = (const bf16_t*)(P.ws + WS_V);
    bf16_t* OB = (bf16_t*)((unsigned char*)P.out + OUT_OB); float* DEN = (float*)((unsigned char*)P.out + OUT_DEN);
    LAS unsigned char* Kt = lds; LAS unsigned char* Vt = lds + 32768;
    for (int ui = blockIdx.x; ui < NB * NH * 96; ui += gridDim.x) {
        const int bh = ui / 96, rem = ui % 96, br = rem >> 5, idx = rem & 31;
        const int d = br == 0 ? 1 : (br == 1 ? 4 : 16), r = br == 0 ? 0 : (br == 1 ? idx >> 3 : idx >> 1), chunk = br == 0 ? idx : (br == 1 ? idx & 7 : idx & 1);
        const int n0 = chunk * 128, b = bh >> 3, h = bh & 7, tok0 = b * SEQ;
        {
            const int rr = tid >> 1, hf = tid & 1; int n = n0 - 128 + rr; n = n < 0 ? 0 : n;
            const size_t go = ((size_t)(tok0 + d * n + r) * AW + h * HD) * 2 + hf * 64;
            const u32x4* ks = (const u32x4*)((const char*)K + go); const u32x4* vs = (const u32x4*)((const char*)V + go);
            u32x4 kv[4], vv[4];
#pragma unroll
            for (int i = 0; i < 4; ++i) { kv[i] = ks[i]; vv[i] = vs[i]; }
#pragma unroll
            for (int i = 0; i < 4; ++i) { const int ch = 4 * hf + i;
                *(LAS u32x4*)(Kt + rr * 128 + ((ch ^ (rr & 7)) << 4)) = kv[i];
                *(LAS u32x4*)(Vt + rr * 128 + (ch << 4)) = vv[i]; }
        }
        __syncthreads();
        {
            const int nq = n0 + 16 * wid + fr;
            const bf16_t* qp = Q + (size_t)(tok0 + d * nq + r) * AW + h * HD + 8 * g;
            const bf16x8 q0 = *(const bf16x8*)qp, q1 = *(const bf16x8*)(qp + 32);
            f32x4 S[9];
#pragma unroll
            for (int jb = 0; jb < 9; ++jb) {
                const int row = 16 * wid + 16 * jb + fr;
                const bf16x8 k0 = *(const LAS bf16x8*)(Kt + row * 128 + ((g ^ (row & 7)) << 4));
                const bf16x8 k1 = *(const LAS bf16x8*)(Kt + row * 128 + (((4 + g) ^ (row & 7)) << 4));
                f32x4 s = (f32x4){0.f, 0.f, 0.f, 0.f};
                s = __builtin_amdgcn_mfma_f32_16x16x32_bf16(k0, q0, s, 0, 0, 0);
                s = __builtin_amdgcn_mfma_f32_16x16x32_bf16(k1, q1, s, 0, 0, 0);
                S[jb] = s;
            }
            float den = 0.f;
            const int jmin = n0 == 0 ? 8 - wid : 0;
#pragma unroll
            for (int jb = 0; jb < 9; ++jb)
#pragma unroll
                for (int e = 0; e < 4; ++e) {
                    const int ki = 4 * g + e;
                    bool ok = jb >= jmin;
                    if (jb == 0) ok = ok && (ki >= fr);
                    if (jb == 8) ok = ok && (ki <= fr);
                    const float p = ok ? __builtin_amdgcn_exp2f(fminf(S[jb][e], 80.f)) : 0.f;
                    S[jb][e] = p; den += p;
                }
            den += __shfl_xor(den, 16); den += __shfl_xor(den, 32);
            f32x4 O[4];
#pragma unroll
            for (int c = 0; c < 4; ++c) O[c] = (f32x4){0.f, 0.f, 0.f, 0.f};
#pragma unroll
            for (int ks = 0; ks < 5; ++ks) {
                u32x4 pw; pw.x = cvt_pk_bf16(S[2 * ks][0], S[2 * ks][1]); pw.y = cvt_pk_bf16(S[2 * ks][2], S[2 * ks][3]);
                if (ks < 4) { pw.z = cvt_pk_bf16(S[2 * ks + 1][0], S[2 * ks + 1][1]); pw.w = cvt_pk_bf16(S[2 * ks + 1][2], S[2 * ks + 1][3]); } else { pw.z = 0u; pw.w = 0u; }
                const bf16x8 pa = __builtin_bit_cast(bf16x8, pw);
                const int row0 = 16 * wid + 32 * ks + 4 * g + (fr >> 2), row1 = ks < 4 ? row0 + 16 : row0;
#pragma unroll
                for (int c = 0; c < 4; ++c) {
                    const s16x4 v0 = __builtin_bit_cast(s16x4, __builtin_amdgcn_ds_read_tr16_b64_v4i16((LAS s16x4*)(Vt + row0 * 128 + 32 * c + 8 * (fr & 3))));
                    const s16x4 v1 = __builtin_bit_cast(s16x4, __builtin_amdgcn_ds_read_tr16_b64_v4i16((LAS s16x4*)(Vt + row1 * 128 + 32 * c + 8 * (fr & 3))));
                    const bf16x8 vb = (bf16x8){v0[0], v0[1], v0[2], v0[3], v1[0], v1[1], v1[2], v1[3]};
                    O[c] = __builtin_amdgcn_mfma_f32_16x16x32_bf16(pa, vb, O[c], 0, 0, 0);
                }
            }
#pragma unroll
            for (int e = 0; e < 4; ++e) {
                const int tq = tok0 + d * (n0 + 16 * wid + 4 * g + e) + r;
                bf16_t* op = OB + ((size_t)br * T + tq) * AW + h * HD + fr;
#pragma unroll
                for (int c = 0; c < 4; ++c) op[16 * c] = (bf16_t)(cvt_pk_bf16(O[c][e], 0.f) & 0xffffu);
            }
            if (g == 0) DEN[((size_t)br * T + tok0 + d * nq + r) * NH + h] = den;
        }
        __syncthreads();
    }
}
template <int W> __device__ __forceinline__ void pool_load(const bf16_t* __restrict__ U, int t, int cc, int cnt, u32x4 (&wv)[W]) {
#pragma unroll
    for (int jj = 0; jj < W; ++jj) { const int back = jj < cnt ? jj : 0; wv[jj] = *(const u32x4*)(U + (size_t)(t - back) * PW + cc); }
}
template <int W> __device__ __forceinline__ void pool_finish(bf16_t* __restrict__ MIX, int t, int cc, int cnt, const u32x4 (&wv)[W]) {
    float o[8], own[8] = {bflo(wv[0].x), bfhi(wv[0].x), bflo(wv[0].y), bfhi(wv[0].y), bflo(wv[0].z), bfhi(wv[0].z), bflo(wv[0].w), bfhi(wv[0].w)};
#pragma unroll
    for (int j = 0; j < 8; ++j) o[j] = own[j];
#pragma unroll
    for (int jj = 1; jj < W; ++jj) { const float m = jj < cnt ? 1.0f : 0.0f;
        o[0] += m * bflo(wv[jj].x); o[1] += m * bfhi(wv[jj].x); o[2] += m * bflo(wv[jj].y); o[3] += m * bfhi(wv[jj].y);
        o[4] += m * bflo(wv[jj].z); o[5] += m * bfhi(wv[jj].z); o[6] += m * bflo(wv[jj].w); o[7] += m * bfhi(wv[jj].w); }
    const float inv = 1.0f / (float)cnt;
    u32x4 w; w.x = cvt_pk_bf16(o[0] * inv - own[0], o[1] * inv - own[1]); w.y = cvt_pk_bf16(o[2] * inv - own[2], o[3] * inv - own[3]);
    w.z = cvt_pk_bf16(o[4] * inv - own[4], o[5] * inv - own[5]); w.w = cvt_pk_bf16(o[6] * inv - own[6], o[7] * inv - own[7]);
    *(u32x4*)(MIX + (size_t)t * D + AW + cc) = w;
}
__device__ __forceinline__ void phase_merge(const Params& P) {
    const bf16_t* __restrict__ OB = (const bf16_t*)((const unsigned char*)P.out + OUT_OB); const float* __restrict__ DEN = (const float*)((const unsigned char*)P.out + OUT_DEN); const bf16_t* __restrict__ U = (const bf16_t*)(P.ws + WS_U);
    bf16_t* __restrict__ MIX = (bf16_t*)(P.ws + WS_MIX);
    int tid = threadIdx.x; asm volatile("" : "+v"(tid));
    const int gt = blockIdx.x * NTHREADS + tid, NT = gridDim.x * NTHREADS;
    for (int it0 = gt; it0 < T * 64; it0 += 4 * NT) {
        u32x4 w[4][3]; float dn[4][3]; int t[4], c8[4];
#pragma unroll
        for (int b = 0; b < 4; ++b) { int it = it0 + b * NT; if (it >= T * 64) it = it0; t[b] = it >> 6; c8[b] = it & 63;
#pragma unroll
            for (int br = 0; br < 3; ++br) { w[b][br] = *(const u32x4*)(OB + ((size_t)br * T + t[b]) * AW + c8[b] * 8); dn[b][br] = DEN[((size_t)br * T + t[b]) * NH + (c8[b] >> 3)]; } }
#pragma unroll
        for (int b = 0; b < 4; ++b) {
            if (it0 + b * NT < T * 64) {
                const float inv = 1.0f / ((dn[b][0] + dn[b][1]) + dn[b][2]);
                u32x4 o;
                o.x = cvt_pk_bf16(((bflo(w[b][0].x) + bflo(w[b][1].x)) + bflo(w[b][2].x)) * inv, ((bfhi(w[b][0].x) + bfhi(w[b][1].x)) + bfhi(w[b][2].x)) * inv);
                o.y = cvt_pk_bf16(((bflo(w[b][0].y) + bflo(w[b][1].y)) + bflo(w[b][2].y)) * inv, ((bfhi(w[b][0].y) + bfhi(w[b][1].y)) + bfhi(w[b][2].y)) * inv);
                o.z = cvt_pk_bf16(((bflo(w[b][0].z) + bflo(w[b][1].z)) + bflo(w[b][2].z)) * inv, ((bfhi(w[b][0].z) + bfhi(w[b][1].z)) + bfhi(w[b][2].z)) * inv);
                o.w = cvt_pk_bf16(((bflo(w[b][0].w) + bflo(w[b][1].w)) + bflo(w[b][2].w)) * inv, ((bfhi(w[b][0].w) + bfhi(w[b][1].w)) + bfhi(w[b][2].w)) * inv);
                *(u32x4*)(MIX + (size_t)t[b] * D + c8[b] * 8) = o;
            }
        }
    }
    for (int it = gt; it < T * 16; it += NT) {
        const int t = it >> 4, ch = (it & 15) * 8, s = t & (SEQ - 1);
        const int c0 = (s + 1) < 2 ? (s + 1) : 2, c1 = (s + 1) < 4 ? (s + 1) : 4, c2 = (s + 1) < 8 ? (s + 1) : 8;
        u32x4 w0[2], w1[4], w2[8];
        pool_load<2>(U, t, ch, c0, w0); pool_load<4>(U, t, 128 + ch, c1, w1); pool_load<8>(U, t, 256 + ch, c2, w2);
        pool_finish<2>(MIX, t, ch, c0, w0); pool_finish<4>(MIX, t, 128 + ch, c1, w1); pool_finish<8>(MIX, t, 256 + ch, c2, w2);
    }
    for (int it = gt; it < T * 16; it += NT) {
        const int t = it >> 4, ch = (it & 15) * 8, s = t & (SEQ - 1); const int c3 = (s + 1) < 16 ? (s + 1) : 16;
        u32x4 w3[16]; pool_load<16>(U, t, 384 + ch, c3, w3); pool_finish<16>(MIX, t, 384 + ch, c3, w3);
    }
}

__device__ __forceinline__ void phase_route(const Params& P, int l, LAS unsigned char* lds) {
    int tid = threadIdx.x; asm volatile("" : "+v"(tid));
    const int wid = __builtin_amdgcn_readfirstlane(tid >> 6), lane = tid & 63, fr = lane & 15, g = lane >> 4;
    LAS int* hist = (LAS int*)(lds + MISC_OFF); LAS int* base = hist + 32;
    const bf16_t* xb = (const bf16_t*)(P.ws + WS_XB); const bf16_t* wr = (const bf16_t*)(P.ws + WS_WR) + (size_t)l * 32 * D;
    unsigned* cnt = (unsigned*)(P.ws + CTL_CNT) + l * NBKT * 16;
    int* list = (int*)(P.ws + WS_LIST); float* gwp = (float*)(P.ws + WS_GW); float* rstd2 = (float*)(P.ws + WS_RSTD2);
    for (int blk = blockIdx.x; blk < T / 64; blk += gridDim.x) {
        if (tid < 32) hist[tid] = 0;
        __syncthreads();
        int bucket = -1, lrank = 0, tok = 0; float wlo = 0.f, whi = 0.f, rstd = 0.f;
        if (wid < 4) {
            tok = blk * 64 + wid * 16 + fr;
            const bf16_t* xp = xb + (size_t)tok * D + 8 * g; const bf16_t* a0p = wr + (size_t)fr * D + 8 * g; const bf16_t* a1p = a0p + 16 * D;
            f32x4 acc0 = (f32x4){0.f, 0.f, 0.f, 0.f}, acc1 = acc0; float ssq = 0.f;
#pragma unroll 8
            for (int kk = 0; kk < 32; ++kk) {
                const bf16x8 xv = *(const bf16x8*)(xp + 32 * kk), a0 = *(const bf16x8*)(a0p + 32 * kk), a1 = *(const bf16x8*)(a1p + 32 * kk);
                acc0 = __builtin_amdgcn_mfma_f32_16x16x32_bf16(a0, xv, acc0, 0, 0, 0);
                acc1 = __builtin_amdgcn_mfma_f32_16x16x32_bf16(a1, xv, acc1, 0, 0, 0);
#pragma unroll
                for (int j = 0; j < 8; ++j) { const float f = bf2f((unsigned short)xv[j]); ssq += f * f; }
            }
            ssq += __shfl_xor(ssq, 16); ssq += __shfl_xor(ssq, 32);
            rstd = rsqrtf(ssq * (1.0f / D) + EPS);
            float gl[4];
#pragma unroll
            for (int e = 0; e < 4; ++e) gl[e] = __shfl(acc1[e], fr) * rstd + P.b_group[l * 4 + e];
            int gs = 0; float gm = gl[0];
#pragma unroll
            for (int e = 1; e < 4; ++e) if (gl[e] > gm) { gm = gl[e]; gs = e; }
            float gden = 0.f;
#pragma unroll
            for (int e = 0; e < 4; ++e) gden += __expf(gl[e] - gm);
            const float ptop = 1.0f / gden;
            if (g == gs) {
                float el[4];
#pragma unroll
                for (int e = 0; e < 4; ++e) el[e] = acc0[e] * rstd + P.b_router[l * 16 + 4 * g + e];
                int i1 = 0;
#pragma unroll
                for (int e = 1; e < 4; ++e) if (el[e] > el[i1]) i1 = e;
                int i2 = -1; float v2 = -3.0e38f;
#pragma unroll
                for (int e = 0; e < 4; ++e) if (e != i1 && el[e] > v2) { v2 = el[e]; i2 = e; }
                const float e2 = __expf(v2 - el[i1]), w1 = ptop / (1.0f + e2), w2 = ptop * e2 / (1.0f + e2);
                const int lo = i1 < i2 ? i1 : i2, hi = i1 < i2 ? i2 : i1;
                wlo = i1 < i2 ? w1 : w2; whi = i1 < i2 ? w2 : w1;
                const int pr = lo == 0 ? hi - 1 : (lo == 1 ? hi + 1 : 5);
                bucket = 6 * gs + pr;
                lrank = atomicAdd((int*)&hist[bucket], 1);
            }
        }
        __syncthreads();
        if (tid < NBKT) { const int hc = hist[tid]; base[tid] = hc ? (int)atomicAdd(cnt + 16 * tid, (unsigned)hc) : 0; }
        __syncthreads();
        if (bucket >= 0) {
            list[bucket * LISTCAP + base[bucket] + lrank] = tok;
            gwp[2 * tok] = wlo; gwp[2 * tok + 1] = whi; rstd2[tok] = rstd;
        }
        __syncthreads();
    }
}

constexpr int NPHASE = 1 + 7 * DEPTH;
__global__ void __launch_bounds__(NTHREADS, 2) fwd(Params P) {
    extern __shared__ __attribute__((aligned(16))) unsigned char lds_raw[];
    LAS unsigned char* lds = (LAS unsigned char*)lds_raw;
    const int tid = threadIdx.x, G = gridDim.x, bid = blockIdx.x;
    const int lo = P.ph_lo, hi = P.ph_hi;
    volatile LAS unsigned* bw = (volatile LAS unsigned*)(lds + MISC_OFF + 1024);
    if (tid < 4) bw[tid] = 0u;
    __syncthreads();
    XcdBarrier bar; bar.bar = (unsigned*)(P.ws + CTL_BAR); bar.x = 0; bar.st = bw;
    const bool multi = (hi - lo) > 1;
    if (multi) bar = xcd_barrier_post((unsigned*)(P.ws + CTL_BAR), bw);
#ifndef PHMASK
#define PHMASK 255
#endif
#define IN(k) (lo <= (k) && (k) < hi)
#define SEAM(k) do { if (IN(k) && IN((k) + 1)) xcd_barrier(bar); } while (0)
    if (IN(0) && (PHMASK & 1)) { phase_prologue(P, lds); if (DUP & 1) phase_prologue(P, lds); }
    SEAM(0);
#pragma unroll 1
    for (int l = 0; l < DEPTH; ++l) {
        const int p0 = 1 + 7 * l;
        const float* ss1 = l == 0 ? (const float*)(P.ws + WS_SS0) : (const float*)(P.ws + WS_SSP);
        if (IN(p0) && (PHMASK & 2)) {
            gb::SchedDense S; S.A = (const char*)(P.ws + WS_XB); S.Bt = (const char*)(P.ws + WS_WIN) + (size_t)l * INW * D * 2; S.lda = D; S.ldb = D; S.nt = D / 64; S.ksw = 1 << 20;
            S.nM = T / 256; S.nN = INW / 256; S.G = G; S.c = bid;
            EpiInProj E{ss1, l == 0 ? 1 : 16, (bf16_t*)(P.ws + WS_Q), P.qg + l * HD, P.kg + l * HD, (const f32x2*)(P.ws + WS_ROPE)};
            gb::gemm_phase<EpiInProj, gb::SchedDense>(lds, S, E);
            if (DUP & 2) gb::gemm_phase<EpiInProj, gb::SchedDense>(lds, S, E);
            if (DUP & 256) { EpiNull E0; gb::gemm_phase<EpiNull, gb::SchedDense>(lds, S, E0); }
        }
        SEAM(p0);
        if (IN(p0 + 1) && (PHMASK & 4)) { phase_attn(P, lds); if (DUP & 4) phase_attn(P, lds); }
        SEAM(p0 + 1);
        if (IN(p0 + 2) && (PHMASK & 8)) { phase_merge(P); if (DUP & 8) phase_merge(P); }
        SEAM(p0 + 2);
        if (IN(p0 + 3) && (PHMASK & 16)) {
            gb::SchedDense S; S.A = (const char*)(P.ws + WS_MIX); S.Bt = (const char*)(P.ws + WS_WOUT) + (size_t)l * D * D * 2; S.lda = D; S.ldb = D; S.nt = D / 64; S.ksw = 1 << 20;
            S.nM = T / 256; S.nN = D / 256; S.G = G; S.c = bid;
            EpiOutProj E{(bf16_t*)(P.ws + WS_XB)};
            gb::gemm_phase<EpiOutProj, gb::SchedDense>(lds, S, E);
        }
        SEAM(p0 + 3);
        if (IN(p0 + 4) && (PHMASK & 32)) { phase_route(P, l, lds); }
        SEAM(p0 + 4);
        if (IN(p0 + 5) && (PHMASK & 64)) {
            LAS int* tb = (LAS int*)(lds + MISC_OFF + 256);
            moe_tables((const unsigned*)(P.ws + CTL_CNT) + l * NBKT * 16, tb);
            SchedMoe<false> S; S.A = (const char*)(P.ws + WS_XB); S.Wt = (const char*)(P.ws + WS_W1) + (size_t)l * NEXP * 512 * D * 2; S.list = (const int*)(P.ws + WS_LIST); S.tb = tb;
            S.lda = D; S.ldb = D; S.nt = D / 64; S.ksw = 1 << 20; S.G = G; S.c = bid;
            EpiMoe1 E{(const int*)(P.ws + WS_LIST), (const float*)(P.ws + WS_RSTD2), (const float*)(P.ws + WS_GW), (bf16_t*)(P.ws + WS_ABUF)};
            gb::gemm_phase<EpiMoe1, SchedMoe<false>>(lds, S, E);
            if (DUP & 64) gb::gemm_phase<EpiMoe1, SchedMoe<false>>(lds, S, E);
        }
        SEAM(p0 + 5);
        if (IN(p0 + 6) && (PHMASK & 128)) {
            LAS int* tb = (LAS int*)(lds + MISC_OFF + 256);
            moe_tables((const unsigned*)(P.ws + CTL_CNT) + l * NBKT * 16, tb);
            SchedMoe<true> S; S.A = (const char*)(P.ws + WS_ABUF); S.Wt = (const char*)(P.ws + WS_W2) + (size_t)l * NEXP * D * DE * 2; S.list = (const int*)(P.ws + WS_LIST); S.tb = tb;
            S.lda = 512; S.ldb = DE; S.nt = 512 / 64; S.ksw = 4; S.G = G; S.c = bid;
            EpiMoe2 E{(const int*)(P.ws + WS_LIST), l + 1 == DEPTH ? P.out : nullptr, (bf16_t*)(P.ws + WS_XB), (float*)(P.ws + WS_SSP)};
            if (DUP & 512) { EpiNull E0; gb::gemm_phase<EpiNull, SchedMoe<true>>(lds, S, E0); }
            gb::gemm_phase<EpiMoe2, SchedMoe<true>>(lds, S, E);
        }
        SEAM(p0 + 6);
    }
#undef IN
#undef SEAM
}

extern "C" void kernel_launch(void* const* d_in, const int* in_sizes, int n_in, void* d_out, int out_size, void* d_ws, size_t ws_size, hipStream_t stream) {
    static int grid = 0;
    if (grid == 0) {
        if (n_in != 16 || out_size != T * D || ws_size < WS_END) { fprintf(stderr, "kernel_launch: unexpected shapes (n_in %d, out %d, ws %zu < %zu); nothing launched\n", n_in, out_size, ws_size, (size_t)WS_END); grid = -1; return; }
        int dev = 0, cus = 0, per_cu = 0;
        if (hipGetDevice(&dev) != hipSuccess || hipDeviceGetAttribute(&cus, hipDeviceAttributeMultiprocessorCount, dev) != hipSuccess) { grid = -1; return; }
        if (hipFuncSetAttribute((const void*)fwd, hipFuncAttributeMaxDynamicSharedMemorySize, LDS_BYTES) != hipSuccess) { fprintf(stderr, "kernel_launch: hipFuncSetAttribute failed\n"); grid = -1; return; }
        if (hipOccupancyMaxActiveBlocksPerMultiprocessor(&per_cu, (const void*)fwd, NTHREADS, LDS_BYTES) != hipSuccess || per_cu < 1) fprintf(stderr, "kernel_launch: occupancy query says %d\n", per_cu);
        (void)hipGetLastError();
        grid = cus;
    }
    if (grid < 0) return;
    (void)hipMemsetAsync(d_ws, 0, CTL_BYTES, stream);
    Params p{};
    p.x = (const float*)d_in[0]; p.norm1 = (const float*)d_in[1]; p.w_in = (const float*)d_in[2]; p.qg = (const float*)d_in[3]; p.kg = (const float*)d_in[4];
    p.w_pool = (const float*)d_in[5]; p.pool_scale = (const float*)d_in[6]; p.w_out = (const float*)d_in[7]; p.norm2 = (const float*)d_in[8];
    p.w_group = (const float*)d_in[9]; p.b_group = (const float*)d_in[10]; p.w_router = (const float*)d_in[11]; p.b_router = (const float*)d_in[12];
    p.w_gate = (const float*)d_in[13]; p.w_up = (const float*)d_in[14]; p.w_down = (const float*)d_in[15];
    p.out = (float*)d_out; p.ws = (unsigned char*)d_ws;
#define RUN(a, b) do { p.ph_lo = (a); p.ph_hi = (b); hipLaunchKernelGGL(fwd, dim3(grid), dim3(NTHREADS), LDS_BYTES, stream, p); } while (0)
#if STAGE == 4
    RUN(0, NPHASE);
#elif STAGE == 3
    for (int ph = 0; ph < NPHASE; ++ph) RUN(ph, ph + 1);
#endif
#undef RUN
}
```
